# Optimizing an MI355X kernel written in HIP

```python
import jax
import jax.numpy as jnp
from jax import lax
import numpy as np

D_MODEL = 1024
BATCH = 4
SEQ = 4096
DEPTH = 2

GRID_W = 64
CTX_LEN = 256
HEAD_DIM = 64
GLA_HEADS = 4
NA_HEADS = 6
SWA_HEADS = 6
SWA_KV_HEADS = 2
GLA_W = GLA_HEADS * HEAD_DIM
NA_W = NA_HEADS * HEAD_DIM
SWA_W = SWA_HEADS * HEAD_DIM
SWA_KV_W = SWA_KV_HEADS * HEAD_DIM
MIX_WIDTH = GLA_W + NA_W + SWA_W
GLA_RANK = 16
GLA_TAU = 16.0
GLA_CHUNK = 64
NA_KH = 8
NA_KW = 16
NA_QW = 16
NA_CB = NA_KW + NA_QW
SWA_WINDOW = 128
SWA_BLOCK = 128
ROPE_THETA = 10000.0
NORM_EPS = 1e-6
D_FF = -(-8 * D_MODEL // (3 * 256)) * 256
IN_SPLITS = (GLA_W, GLA_W, GLA_W, GLA_W, GLA_RANK, GLA_RANK, NA_W, NA_W, NA_W, SWA_W, SWA_KV_W, SWA_KV_W)
IN_WIDTH = sum(IN_SPLITS)

kernel_name = 'hybrid_parallel_head_groups_dit'


def rms_norm(x, g):
    xf = x.astype(jnp.float32)
    y = xf * lax.rsqrt(jnp.mean(xf * xf, axis=-1, keepdims=True) + NORM_EPS)
    return (y * g.astype(jnp.float32)).astype(x.dtype)


def split_cols(p):
    bounds = [int(b) for b in np.cumsum(IN_SPLITS)[:-1]]
    return jnp.split(p, bounds, axis=-1)


def split_heads(a, n_heads):
    return a.reshape(a.shape[:-1] + (n_heads, HEAD_DIM))


def axial_rope(n_tokens):
    t = jnp.arange(n_tokens, dtype=jnp.int32)
    row = (t // GRID_W).astype(jnp.float32)
    col = (t % GRID_W).astype(jnp.float32)
    n_freq = HEAD_DIM // 4
    inv_freq = ROPE_THETA ** (-jnp.arange(n_freq, dtype=jnp.float32) / n_freq)
    ang = jnp.concatenate([row[:, None] * inv_freq, col[:, None] * inv_freq], axis=-1)
    return jnp.cos(ang), jnp.sin(ang)


def apply_rope(a, cos, sin):
    half = HEAD_DIM // 2
    af = a.astype(jnp.float32)
    a1, a2 = af[..., :half], af[..., half:]
    cs = cos[None, :, None, :]
    sn = sin[None, :, None, :]
    return jnp.concatenate([a1 * cs - a2 * sn, a1 * sn + a2 * cs], axis=-1).astype(a.dtype)


def gla_heads(a):
    B, T, _ = a.shape
    return a.reshape(B, T, GLA_HEADS, HEAD_DIM).transpose(0, 2, 1, 3)


def gla_log_decay(z_low, w2, b2):
    z = (z_low @ w2 + b2).astype(jnp.float32)
    return gla_heads(jax.nn.log_sigmoid(z) / GLA_TAU)


def gla_chunked(q, k, v, log_a, s0):
    B, H, T, dk = q.shape
    dv = v.shape[-1]
    n = T // GLA_CHUNK

    def chunks(a):
        return a.astype(jnp.float32).reshape(B, H, n, GLA_CHUNK, a.shape[-1])

    qc, kc, vc, la = chunks(q), chunks(k), chunks(v), chunks(log_a)
    b = jnp.cumsum(la, axis=3)
    b_last = b[:, :, :, -1:, :]
    q_in = qc * jnp.exp(b)
    k_in = kc * jnp.exp(-b)
    k_end = kc * jnp.exp(b_last - b)
    lower = jnp.tril(jnp.ones((GLA_CHUNK, GLA_CHUNK), dtype=bool))
    a_intra = jnp.where(lower, jnp.einsum('bhncd,bhnsd->bhncs', q_in, k_in), 0.0)
    o_intra = jnp.einsum('bhncs,bhnse->bhnce', a_intra, vc)
    chunk_state = jnp.einsum('bhnsd,bhnse->bhnde', k_end, vc)
    chunk_decay = jnp.exp(b_last[:, :, :, 0, :])

    def step(state, inp):
        dec, cs = inp
        return dec[..., None] * state + cs, state

    s_final, s_enter = lax.scan(step, s0, (jnp.moveaxis(chunk_decay, 2, 0), jnp.moveaxis(chunk_state, 2, 0)))
    o_inter = jnp.einsum('bhncd,nbhde->bhnce', q_in, s_enter)
    o = (o_intra + o_inter).reshape(B, H, T, dv).astype(v.dtype)
    return o, s_final


def gla_final_state(k, v, log_a):
    A = jnp.cumsum(log_a.astype(jnp.float32), axis=2)
    w = jnp.exp(A[:, :, -1:, :] - A)
    return jnp.einsum('bhtd,bhte->bhde', k.astype(jnp.float32) * w, v.astype(jnp.float32))


def gla_output(o, g, norm_g):
    B, H, T, dv = o.shape
    o = rms_norm(o.transpose(0, 2, 1, 3), norm_g.reshape(H, dv))
    return o.reshape(B, T, H * dv) * jax.nn.silu(g)


def gla_mixer(parts, parts_c, wa2_f, ba_f, wa2_b, ba_b, norm_g, need_ctx_out):
    q, k, v, g, za_f, za_b = parts
    qc, kc, vc, gc, zac_f, zac_b = parts_c
    scale = HEAD_DIM ** -0.5

    def flip(a):
        return jnp.flip(a, axis=2)

    K_c, V_c = gla_heads(kc), gla_heads(vc)
    la_cf = gla_log_decay(zac_f, wa2_f, ba_f)
    la_cb = gla_log_decay(zac_b, wa2_b, ba_b)
    if need_ctx_out:
        Q_c = gla_heads(qc) * scale
        zeros = jnp.zeros(K_c.shape[:2] + (HEAD_DIM, HEAD_DIM), jnp.float32)
        oc_f, s_f = gla_chunked(Q_c, K_c, V_c, la_cf, zeros)
        oc_b, s_b = gla_chunked(flip(Q_c), flip(K_c), flip(V_c), flip(la_cb), zeros)
        yc = gla_output(oc_f + flip(oc_b), gc, norm_g)
    else:
        s_f = gla_final_state(K_c, V_c, la_cf)
        s_b = gla_final_state(flip(K_c), flip(V_c), flip(la_cb))
        yc = None
    Q, K, V = gla_heads(q) * scale, gla_heads(k), gla_heads(v)
    o_f, _ = gla_chunked(Q, K, V, gla_log_decay(za_f, wa2_f, ba_f), s_f)
    o_b, _ = gla_chunked(flip(Q), flip(K), flip(V), flip(gla_log_decay(za_b, wa2_b, ba_b)), s_b)
    y = gla_output(o_f + flip(o_b), g, norm_g)
    return y, yc


def context_attention(qc, kc, vc, sink):
    B, L, Hq, dh = qc.shape
    Hkv = kc.shape[2]
    G = Hq // Hkv
    s = jnp.einsum('bqhgd,bkhd->bhgqk', qc.reshape(B, L, Hkv, G, dh), kc).astype(jnp.float32) * dh ** -0.5
    if sink is None:
        p = jax.nn.softmax(s, axis=-1)
    else:
        s_sink = jnp.broadcast_to(sink.astype(jnp.float32).reshape(1, Hkv, G, 1, 1), s.shape[:-1] + (1,))
        p = jax.nn.softmax(jnp.concatenate([s, s_sink], axis=-1), axis=-1)[..., :-1]
    o = jnp.einsum('bhgqk,bkhd->bqhgd', p.astype(vc.dtype), vc)
    return o.reshape(B, L, Hq * dh)


def neighborhood_attention(q, k, v, kc, vc, rpb):
    B, T, H, dh = q.shape
    rows = T // GRID_W
    kh = min(NA_KH, rows)
    ncb = GRID_W // NA_QW
    r = np.arange(rows)
    row_idx = np.clip(r - kh // 2, 0, rows - kh)[:, None] + np.arange(kh)[None, :]
    q_cols = np.arange(GRID_W).reshape(ncb, NA_QW)
    win_start = np.clip(q_cols - NA_KW // 2, 0, GRID_W - NA_KW)
    col_idx = np.clip(np.arange(ncb) * NA_QW - NA_KW // 2, 0, GRID_W - NA_CB)[:, None] + np.arange(NA_CB)[None, :]
    key_col = col_idx[:, None, :]
    valid = (key_col >= win_start[:, :, None]) & (key_col < win_start[:, :, None] + NA_KW)
    dr = row_idx - r[:, None] + NA_KH - 1
    dc = np.clip(key_col - q_cols[:, :, None] + NA_KW - 1, 0, 2 * NA_KW - 2)
    bias = rpb.astype(jnp.float32)[:, dr[:, None, None, :, None], dc[None, :, :, None, :]]
    bias = jnp.where(valid[None, None, :, :, None, :], bias, -jnp.inf)

    q_blk = q.reshape(B, rows, ncb, NA_QW, H, dh)
    k_grid = k.reshape(B, rows, GRID_W, H, dh)
    v_grid = v.reshape(B, rows, GRID_W, H, dh)
    ri = row_idx[:, None, :, None]
    ci = col_idx[None, :, None, :]
    k_blk = k_grid[:, ri, ci]
    v_blk = v_grid[:, ri, ci]
    scale = dh ** -0.5
    s_loc = jnp.einsum('brnqhd,brnkchd->bhrnqkc', q_blk, k_blk).astype(jnp.float32) * scale + bias
    n_loc = kh * NA_CB
    s_loc = s_loc.reshape(s_loc.shape[:5] + (n_loc,))
    s_ctx = jnp.einsum('brnqhd,blhd->bhrnql', q_blk, kc).astype(jnp.float32) * scale
    p = jax.nn.softmax(jnp.concatenate([s_loc, s_ctx], axis=-1), axis=-1)
    p_loc = p[..., :n_loc].reshape(p.shape[:5] + (kh, NA_CB)).astype(v.dtype)
    p_ctx = p[..., n_loc:].astype(vc.dtype)
    o = (jnp.einsum('bhrnqkc,brnkchd->brnqhd', p_loc, v_blk)
         + jnp.einsum('bhrnql,blhd->brnqhd', p_ctx, vc))
    return o.reshape(B, T, H * dh)


def sliding_window_attention(q, k, v, kc, vc, sink):
    B, T, Hq, dh = q.shape
    Hkv = k.shape[2]
    G = Hq // Hkv
    bs = SWA_BLOCK
    nb = T // bs
    qb = q.reshape(B, nb, bs, Hkv, G, dh)
    pad = ((0, 0), (bs, bs), (0, 0), (0, 0))
    kp, vp = jnp.pad(k, pad), jnp.pad(v, pad)
    idx = np.arange(nb)[:, None] * bs + np.arange(3 * bs)[None, :]
    kb, vb = kp[:, idx], vp[:, idx]
    kpos = idx - bs
    qpos = np.arange(T).reshape(nb, bs)
    valid = ((np.abs(qpos[:, :, None] - kpos[:, None, :]) <= SWA_WINDOW)
             & (kpos[:, None, :] >= 0) & (kpos[:, None, :] < T))
    scale = dh ** -0.5
    s_loc = jnp.einsum('bnqhgd,bnkhd->bhgnqk', qb, kb).astype(jnp.float32) * scale
    s_loc = jnp.where(valid, s_loc, -jnp.inf)
    s_ctx = jnp.einsum('bnqhgd,blhd->bhgnql', qb, kc).astype(jnp.float32) * scale
    s_sink = jnp.broadcast_to(sink.astype(jnp.float32).reshape(1, Hkv, G, 1, 1, 1), s_loc.shape[:-1] + (1,))
    p = jax.nn.softmax(jnp.concatenate([s_loc, s_ctx, s_sink], axis=-1), axis=-1)
    n_loc = 3 * bs
    L = kc.shape[1]
    p_loc = p[..., :n_loc].astype(v.dtype)
    p_ctx = p[..., n_loc:n_loc + L].astype(vc.dtype)
    o = (jnp.einsum('bhgnqk,bnkhd->bnqhgd', p_loc, vb)
         + jnp.einsum('bhgnql,blhd->bnqhgd', p_ctx, vc))
    return o.reshape(B, T, Hq * dh)


def token_mixers(h, hc, w_in, w_out, wa2_f, ba_f, wa2_b, ba_b, gla_norm, na_rpb, swa_sink, cos, sin, need_ctx_out):
    p = split_cols(h @ w_in)
    pc = split_cols(hc @ w_in)
    y_gla, yc_gla = gla_mixer(p[0:6], pc[0:6], wa2_f, ba_f, wa2_b, ba_b, gla_norm, need_ctx_out)
    nq, nk, nv = (split_heads(a, NA_HEADS) for a in p[6:9])
    nkc, nvc = split_heads(pc[7], NA_HEADS), split_heads(pc[8], NA_HEADS)
    y_na = neighborhood_attention(nq, nk, nv, nkc, nvc, na_rpb)
    sq = apply_rope(split_heads(p[9], SWA_HEADS), cos, sin)
    sk = apply_rope(split_heads(p[10], SWA_KV_HEADS), cos, sin)
    sv = split_heads(p[11], SWA_KV_HEADS)
    skc, svc = split_heads(pc[10], SWA_KV_HEADS), split_heads(pc[11], SWA_KV_HEADS)
    y_swa = sliding_window_attention(sq, sk, sv, skc, svc, swa_sink)
    y = jnp.concatenate([y_gla, y_na, y_swa], axis=-1) @ w_out
    if not need_ctx_out:
        return y, None
    yc_na = context_attention(split_heads(pc[6], NA_HEADS), nkc, nvc, None)
    yc_swa = context_attention(split_heads(pc[9], SWA_HEADS), skc, svc, swa_sink)
    yc = jnp.concatenate([yc_gla, yc_na, yc_swa], axis=-1) @ w_out
    return y, yc


def swiglu(h, w_gate, w_up, w_down):
    return (jax.nn.silu(h @ w_gate) * (h @ w_up)) @ w_down


def setup_inputs(seed: int = 0) -> dict:
    key = jax.random.key(seed)
    ks = jax.random.split(key, 24)
    f32 = jnp.float32
    D = D_MODEL

    def nrm(k, shape, s):
        return jax.random.normal(k, shape, f32) * s

    return {
        'x': nrm(ks[0], (BATCH, SEQ, D), 1.0),
        'c': nrm(ks[1], (BATCH, D), 1.0),
        'ctx': nrm(ks[2], (BATCH, CTX_LEN, D), 1.0),
        'c_ctx': nrm(ks[3], (D,), 1.0),
        'w_mod': nrm(ks[4], (DEPTH, D, 6 * D), 0.5 * D ** -0.5),
        'b_mod': nrm(ks[5], (DEPTH, 6 * D), 0.02),
        'norm_mix': 1.0 + nrm(ks[6], (DEPTH, D), 0.05),
        'norm_ffn': 1.0 + nrm(ks[7], (DEPTH, D), 0.05),
        'w_in': nrm(ks[8], (DEPTH, D, IN_WIDTH), D ** -0.5),
        'gla_wa2_f': nrm(ks[9], (DEPTH, GLA_RANK, GLA_W), GLA_RANK ** -0.5),
        'gla_ba_f': nrm(ks[10], (DEPTH, GLA_W), 0.5),
        'gla_wa2_b': nrm(ks[11], (DEPTH, GLA_RANK, GLA_W), GLA_RANK ** -0.5),
        'gla_ba_b': nrm(ks[12], (DEPTH, GLA_W), 0.5),
        'gla_norm': 1.0 + nrm(ks[13], (DEPTH, GLA_W), 0.05),
        'na_rpb': nrm(ks[14], (DEPTH, NA_HEADS, 2 * NA_KH - 1, 2 * NA_KW - 1), 0.1),
        'swa_sink': nrm(ks[15], (DEPTH, SWA_HEADS), 0.5),
        'w_out': nrm(ks[16], (DEPTH, MIX_WIDTH, D), MIX_WIDTH ** -0.5),
        'w_gate': nrm(ks[17], (DEPTH, D, D_FF), D ** -0.5),
        'w_up': nrm(ks[18], (DEPTH, D, D_FF), D ** -0.5),
        'w_down': nrm(ks[19], (DEPTH, D_FF, D), D_FF ** -0.5),
        'final_norm': 1.0 + nrm(ks[20], (D,), 0.05),
    }


def reference(x, c, ctx, c_ctx, w_mod, b_mod, norm_mix, norm_ffn, w_in, gla_wa2_f, gla_ba_f, gla_wa2_b, gla_ba_b,
              gla_norm, na_rpb, swa_sink, w_out, w_gate, w_up, w_down, final_norm):
    T = x.shape[1]
    cos, sin = axial_rope(T)
    s_lat = jax.nn.silu(c)
    s_ctx = jax.nn.silu(c_ctx)
    xc = ctx
    for i in range(DEPTH):
        need_ctx_out = i < DEPTH - 1
        mod = (s_lat @ w_mod[i] + b_mod[i])[:, None, :]
        mod_c = s_ctx @ w_mod[i] + b_mod[i]
        sh1, sc1, g1, sh2, sc2, g2 = jnp.split(mod, 6, axis=-1)
        sh1c, sc1c, g1c, sh2c, sc2c, g2c = jnp.split(mod_c, 6, axis=-1)
        h = rms_norm(x, norm_mix[i]) * (1.0 + sc1) + sh1
        hc = rms_norm(xc, norm_mix[i]) * (1.0 + sc1c) + sh1c
        y, yc = token_mixers(h, hc, w_in[i], w_out[i], gla_wa2_f[i], gla_ba_f[i], gla_wa2_b[i], gla_ba_b[i],
                             gla_norm[i], na_rpb[i], swa_sink[i], cos, sin, need_ctx_out)
        x = x + g1 * y
        h = rms_norm(x, norm_ffn[i]) * (1.0 + sc2) + sh2
        x = x + g2 * swiglu(h, w_gate[i], w_up[i], w_down[i])
        if need_ctx_out:
            xc = xc + g1c * yc
            hc = rms_norm(xc, norm_ffn[i]) * (1.0 + sc2c) + sh2c
            xc = xc + g2c * swiglu(hc, w_gate[i], w_up[i], w_down[i])
    return rms_norm(x, final_norm)
```

```cpp
#include <hip/hip_runtime.h>
#include <hip/hip_cooperative_groups.h>
#include <stdint.h>
#include <stdio.h>
namespace cg = cooperative_groups;

typedef __attribute__((ext_vector_type(8))) short bf16x8;
typedef __attribute__((ext_vector_type(4))) float f32x4;
typedef __attribute__((ext_vector_type(4))) unsigned u32x4;
typedef unsigned short bf16_t;
#define DI __device__ __forceinline__
#define MFMA16(a, b, c) __builtin_amdgcn_mfma_f32_16x16x32_bf16((a), (b), (c), 0, 0, 0)

constexpr int NB = 4, T = 4096, L = 256, S = 4352, R = NB * S, D = 1024, DFF = 2816;
constexpr int PW = 2048;
constexpr int NIN = 2816;
constexpr int NIN_ROWS = 2880;
constexpr int NCH = 68;
constexpr float EPS = 1e-6f;
constexpr int NTHR = 512;
constexpr float LOG2E = 1.4426950408889634f;
constexpr float QSCALE = 0.125f * 1.4426950408889634f;

constexpr size_t OFF_XC   = 0;
constexpr size_t OFF_H    = OFF_XC + (size_t)NB * L * D * 4;
constexpr size_t OFF_P    = OFF_H + (size_t)R * D * 2;
constexpr size_t OFF_VT   = OFF_P + (size_t)R * PW * 2;
constexpr size_t OFF_CST  = OFF_VT + (size_t)NB * 12 * 64 * S * 2;
constexpr size_t OFF_DEC  = OFF_CST + (size_t)NB * 4 * 2 * NCH * 4096 * 4;
constexpr size_t OFF_ZA   = OFF_DEC + (size_t)NB * 4 * 2 * NCH * 64 * 4;
constexpr size_t OFF_MOD  = OFF_ZA + (size_t)R * 32 * 4;
constexpr size_t OFF_ROPE = OFF_MOD + (size_t)2 * 5 * 6144 * 4;
constexpr size_t OFF_WIN  = OFF_ROPE + (size_t)T * 32 * 8;
constexpr size_t OFF_WOUT = OFF_WIN + (size_t)2 * NIN_ROWS * D * 2;
constexpr size_t OFF_WGU  = OFF_WOUT + (size_t)2 * D * D * 2;
constexpr size_t OFF_WD   = OFF_WGU + (size_t)2 * 2 * DFF * D * 2;
constexpr size_t OFF_BAR  = OFF_WD + (size_t)2 * D * DFF * 2;
constexpr size_t OFF_SLF  = OFF_BAR + 16384;
constexpr size_t OFF_SLI  = OFF_SLF + (size_t)4 * NB * L * D * 4;
constexpr size_t WS_END   = OFF_SLI + (size_t)3 * NB * L * D * 4;
constexpr size_t OFF_BC   = OFF_SLF;
static_assert((size_t)NB * 4 * 2 * NCH * 4096 * 2 <= WS_END - OFF_SLF, "decay buffer must fit the slab region");
static_assert(WS_END <= (size_t)256 * 1024 * 1024, "workspace layout exceeds the guaranteed 256 MiB");
static_assert((size_t)8 * NB * L * D * 4 <= (size_t)NB * 4 * 2 * NCH * 4096 * 4, "down-projection slabs 0..7 must fit the GLA state buffer");

constexpr int SMEM_BYTES = 131072;

struct Params {
  const float *x, *c, *ctx, *c_ctx, *w_mod, *b_mod, *norm_mix, *norm_ffn, *w_in, *wa2_f, *ba_f, *wa2_b, *ba_b,
      *gla_norm, *na_rpb, *swa_sink, *w_out, *w_gate, *w_up, *w_down, *final_norm;
  float* out;
  char* ws;
};

DI int otid() { int t = threadIdx.x; asm volatile("" : "+v"(t)); return t; }
typedef __bf16 hwbf2 __attribute__((ext_vector_type(2)));
typedef float f32x2 __attribute__((ext_vector_type(2)));
DI unsigned pack2(float a, float b) { f32x2 v; v.x = a; v.y = b; return __builtin_bit_cast(unsigned, __builtin_convertvector(v, hwbf2)); }
DI bf16_t f2bf(float x) { return (bf16_t)(pack2(x, 0.f) & 0xffffu); }
DI float bf2f(bf16_t h) { return __uint_as_float(((unsigned)h) << 16); }
DI float silu_f(float v) { return v * __builtin_amdgcn_rcpf(1.f + __builtin_amdgcn_exp2f(-1.4426950408889634f * v)); }
#define DPPF(v, ctrl) __builtin_bit_cast(float, __builtin_amdgcn_update_dpp(0, __builtin_bit_cast(int, (v)), (ctrl), 0xF, 0xF, true))
DI float max16(float v) { v = fmaxf(v, DPPF(v, 0xB1)); v = fmaxf(v, DPPF(v, 0x4E)); v = fmaxf(v, DPPF(v, 0x141)); v = fmaxf(v, DPPF(v, 0x140)); return v; }
DI float sum16(float v) { v += DPPF(v, 0xB1); v += DPPF(v, 0x4E); v += DPPF(v, 0x141); v += DPPF(v, 0x140); return v; }
DI float xor_lane(float v, int lane, int mask) { return __builtin_bit_cast(float, __builtin_amdgcn_ds_bpermute((lane ^ mask) << 2, __builtin_bit_cast(int, v))); }
DI float log_sigmoid_f(float z) { return fminf(z, 0.f) - __logf(1.f + __expf(-fabsf(z))); }

DI float* slab_i(const Params& p, int sl) { return (float*)(p.ws + (sl < 8 ? OFF_CST + (size_t)sl * NB * L * D * 4 : OFF_SLI + (size_t)(sl - 8) * NB * L * D * 4)); }
DI float* xrow(const Params& p, int row) {
  int b = row / S, pos = row - b * S;
  return pos < L ? (float*)(p.ws + OFF_XC) + (size_t)(b * L + pos) * D : p.out + (size_t)(b * T + pos - L) * D;
}
DI const float* xrow_in(const Params& p, int row) {
  int b = row / S, pos = row - b * S;
  return pos < L ? p.ctx + (size_t)(b * L + pos) * D : p.x + (size_t)(b * T + pos - L) * D;
}

DI void mod_item(const Params& p, int item, char* smem) {
  float* sS = (float*)smem;
  float* sR = sS + 5 * 256;
  const int tid = otid();
  const int l = item / 384, rem = item - l * 384, n0 = (rem >> 2) * 64, k0 = (rem & 3) * 256;
  __syncthreads();
  for (int i = tid; i < 5 * 256; i += NTHR) {
    int v = i >> 8, k = k0 + (i & 255);
    float cv = v < 4 ? p.c[v * 1024 + k] : p.c_ctx[k];
    sS[i] = cv / (1.f + expf(-cv));
  }
  const int col = tid & 63, kq = tid >> 6;
  const float* wp = p.w_mod + ((size_t)l * 1024 + k0 + kq * 32) * 6144 + n0 + col;
  float wv[32];
#pragma unroll
  for (int k = 0; k < 32; ++k) wv[k] = wp[(size_t)k * 6144];
  __syncthreads();
  float acc[5] = {0.f, 0.f, 0.f, 0.f, 0.f};
#pragma unroll
  for (int k = 0; k < 32; ++k)
#pragma unroll
    for (int v = 0; v < 5; ++v) acc[v] += sS[v * 256 + kq * 32 + k] * wv[k];
#pragma unroll
  for (int v = 0; v < 5; ++v) sR[(kq * 5 + v) * 64 + col] = acc[v];
  __syncthreads();
  if (tid < 320) {
    int v = tid >> 6, cc = tid & 63;
    float s = (rem & 3) == 0 ? p.b_mod[l * 6144 + n0 + cc] : 0.f;
#pragma unroll
    for (int q = 0; q < 8; ++q) s += sR[(q * 5 + v) * 64 + cc];
    (void)__hip_atomic_fetch_add((float*)(p.ws + OFF_MOD) + (size_t)(l * 5 + v) * 6144 + n0 + cc, s, __ATOMIC_RELAXED, __HIP_MEMORY_SCOPE_AGENT);
  }
}

DI void rope_item(const Params& p, int item) {
  int idx = item * NTHR + otid();
  int t = idx >> 5, i = idx & 31, f = i & 15;
  float pos = (float)(i < 16 ? (t >> 6) : (t & 63));
  float inv_freq = exp2f(-(float)f * 0.83048202372184058696f);
  float ang = pos * inv_freq;
  float n = rintf(ang * 0.15915494309189533577f);
  float r = fmaf(-n, 6.28125f, ang);
  r = fmaf(-n, 0.0019353071795864769f, r);
  float2 cs; cs.x = __cosf(r); cs.y = __sinf(r);
  ((float2*)(p.ws + OFF_ROPE))[idx] = cs;
}

DI void conv_item(const Params& p, int kind, int layer, int nt, int kt, char* smem) {
  float* sT = (float*)smem;
  const int tid = otid();
  const float* src; const float* src2 = nullptr; int ldsrc; bf16_t* dst; int ldd;
  if (kind == 0) { src = p.w_in + (size_t)layer * D * 2848; ldsrc = 2848; dst = (bf16_t*)(p.ws + OFF_WIN) + (size_t)layer * NIN_ROWS * D; ldd = D; }
  else if (kind == 1) { src = p.w_out + (size_t)layer * D * D; ldsrc = D; dst = (bf16_t*)(p.ws + OFF_WOUT) + (size_t)layer * D * D; ldd = D; }
  else if (kind == 2) { src = p.w_gate + (size_t)layer * D * DFF; src2 = p.w_up + (size_t)layer * D * DFF; ldsrc = DFF; dst = (bf16_t*)(p.ws + OFF_WGU) + (size_t)layer * 2 * DFF * D; ldd = D; }
  else { src = p.w_down + (size_t)layer * DFF * D; ldsrc = D; dst = (bf16_t*)(p.ws + OFF_WD) + (size_t)layer * D * DFF; ldd = DFF; }
  const int n0 = nt * 64, k0 = kt * 128;
  __syncthreads();
  f32x4 v[4];
#pragma unroll
  for (int i = 0; i < 4; ++i) {
    int idx = i * NTHR + tid, kk = idx >> 4, np = n0 + (idx & 15) * 4;
    const float* sp = nullptr;
    if (kind == 0) {
      int sc;
      if (np < 1024) sc = np;
      else if (np < 2176) sc = np + 32;
      else if (np < 2688) { int rel = np - 2176, head = rel >> 6, wi = rel & 63; int dd = ((wi >> 5) << 4) + (wi & 15) + (((wi >> 4) & 1) << 5); sc = 2208 + head * 64 + dd; }
      else if (np < 2816) sc = np + 32;
      else if (np < 2848) sc = np - 2816 + 1024;
      else sc = -1;
      if (sc >= 0) sp = src + (size_t)(k0 + kk) * ldsrc + sc;
    } else if (kind == 2) {
      int j = np >> 5, rr = np & 31;
      sp = (rr < 16 ? src + j * 16 + rr : src2 + j * 16 + rr - 16) + (size_t)(k0 + kk) * ldsrc;
    } else {
      sp = src + (size_t)(k0 + kk) * ldsrc + np;
    }
    v[i] = sp ? *(const f32x4*)sp : (f32x4){0.f, 0.f, 0.f, 0.f};
  }
#pragma unroll
  for (int i = 0; i < 4; ++i) {
    int idx = i * NTHR + tid, kk = idx >> 4, nn = (idx & 15) * 4;
    *(f32x4*)(sT + kk * 68 + nn) = v[i];
  }
  __syncthreads();
#pragma unroll
  for (int i = 0; i < 2; ++i) {
    int idx = i * NTHR + tid, nn = idx >> 4, kc = (idx & 15) * 8;
    float e[8];
#pragma unroll
    for (int q = 0; q < 8; ++q) e[q] = sT[(kc + q) * 68 + nn];
    u32x4 o; o.x = pack2(e[0], e[1]); o.y = pack2(e[2], e[3]); o.z = pack2(e[4], e[5]); o.w = pack2(e[6], e[7]);
    *(u32x4*)(dst + (size_t)(n0 + nn) * ldd + k0 + kc) = o;
  }
}

DI void norm_phase(const Params& p, int layer, int mode) {
  const int lane = otid() & 63;
  const int gw = blockIdx.x * 8 + (otid() >> 6), nw = gridDim.x * 8;
  const float* gvec = mode == 0 ? p.norm_mix + layer * D : (mode == 1 ? p.norm_ffn + layer * D : p.final_norm);
  const float* MOD = (const float*)(p.ws + OFF_MOD);
  bf16_t* H = (bf16_t*)(p.ws + OFF_H);
  const bool skip_ctx = (mode == 2) || (mode == 1 && layer == 1);
  const int nrows = skip_ctx ? NB * T : R;
  f32x4 v[4], vn[4];
  if (gw < nrows) {
    const int row_ = skip_ctx ? (gw / T) * S + L + (gw % T) : gw;
    const float* src_ = (mode == 0 && layer == 0) ? xrow_in(p, row_) : xrow(p, row_);
#pragma unroll
    for (int i = 0; i < 4; ++i) v[i] = *(const f32x4*)(src_ + i * 256 + lane * 4);
  }
  for (int ri = gw; ri < nrows; ri += nw) {
    int row = skip_ctx ? (ri / T) * S + L + (ri % T) : ri;
    int b = row / S, pos = row - b * S;
    if (ri + nw < nrows) {
      const int rn_ = ri + nw, row_ = skip_ctx ? (rn_ / T) * S + L + (rn_ % T) : rn_;
      const float* src_ = (mode == 0 && layer == 0) ? xrow_in(p, row_) : xrow(p, row_);
#pragma unroll
      for (int i = 0; i < 4; ++i) vn[i] = *(const f32x4*)(src_ + i * 256 + lane * 4);
    }
    float ss = 0.f;
    if (pos < L && ((mode == 1 && layer == 0) || (mode == 0 && layer == 1))) {
      const size_t co = (size_t)(b * L + pos) * D;
      const int nsl = mode == 1 ? 4 : 11;
      for (int sl = 0; sl < nsl; ++sl) {
        const float* sp = (mode == 1 ? (const float*)(p.ws + OFF_SLF) + (size_t)sl * NB * L * D : slab_i(p, sl)) + co;
#pragma unroll
        for (int i = 0; i < 4; ++i) v[i] += *(const f32x4*)(sp + i * 256 + lane * 4);
      }
      if (mode == 1) {
        float* xd = xrow(p, row);
#pragma unroll
        for (int i = 0; i < 4; ++i) *(f32x4*)(xd + i * 256 + lane * 4) = v[i];
      }
    }
#pragma unroll
    for (int i = 0; i < 4; ++i) ss += v[i].x * v[i].x + v[i].y * v[i].y + v[i].z * v[i].z + v[i].w * v[i].w;
    ss = sum16(ss);
    ss += xor_lane(ss, lane, 16);
    ss += xor_lane(ss, lane, 32);
    const float rstd = rsqrtf(ss * (1.f / 1024.f) + EPS);
    if (mode == 2) {
      float* dst = p.out + (size_t)(b * T + pos - L) * D;
#pragma unroll
      for (int i = 0; i < 4; ++i) {
        float4 g = *(const float4*)(gvec + i * 256 + lane * 4);
        float4 o; o.x = v[i].x * rstd * g.x; o.y = v[i].y * rstd * g.y; o.z = v[i].z * rstd * g.z; o.w = v[i].w * rstd * g.w;
        *(float4*)(dst + i * 256 + lane * 4) = o;
      }
    } else {
      const int mv = pos < L ? 4 : b;
      const float* sh = MOD + (size_t)(layer * 5 + mv) * 6144 + (mode == 0 ? 0 : 3072);
      const float* sc = sh + 1024;
      if (mode == 0 && layer == 0) {
        float* xd = xrow(p, row);
#pragma unroll
        for (int i = 0; i < 4; ++i) *(f32x4*)(xd + i * 256 + lane * 4) = v[i];
      }
#pragma unroll
      for (int i = 0; i < 4; ++i) {
        float4 g = *(const float4*)(gvec + i * 256 + lane * 4);
        float4 s1 = *(const float4*)(sc + i * 256 + lane * 4);
        float4 s0 = *(const float4*)(sh + i * 256 + lane * 4);
        float a0 = v[i].x * rstd * g.x * (1.f + s1.x) + s0.x;
        float a1 = v[i].y * rstd * g.y * (1.f + s1.y) + s0.y;
        float a2 = v[i].z * rstd * g.z * (1.f + s1.z) + s0.z;
        float a3 = v[i].w * rstd * g.w * (1.f + s1.w) + s0.w;
        uint2 o; o.x = pack2(a0, a1); o.y = pack2(a2, a3);
        *(uint2*)(H + (size_t)row * D + i * 256 + lane * 4) = o;
      }
    }
#pragma unroll
    for (int i = 0; i < 4; ++i) v[i] = vn[i];
  }
}

enum { EPI_IN = 0, EPI_RES1 = 1, EPI_GU = 2, EPI_RES2 = 3 };
constexpr int HT_B = 128 * 64 * 2;

DI int lds_byte(int r, int c) { int st = (r >> 4) * 2 + (c >> 5), rr = r & 15, cc = c & 31, ob = rr * 64 + cc * 2; return st * 1024 + (ob ^ (((ob >> 9) & 1) << 5)); }
DI void stage_rc(int b, int& Rr, int& Cc) { int st = b >> 10, sb = b & 1023, swz = sb ^ (((sb >> 9) & 1) << 5); Rr = (st >> 1) * 16 + (swz >> 6); Cc = (st & 1) * 32 + ((swz & 63) >> 1); }

struct Tile { int K, koff, brow, bcol, atomic; };
DI int mtile_row0(int idx, bool skip_ctx) { return skip_ctx ? (idx >> 4) * S + L + (idx & 15) * 256 : idx * 256; }
template <int EPI>
DI Tile tile_of(int layer, int t) {
  if constexpr (EPI == EPI_IN) { return (Tile){D, 0, (t / 11) * 256, (t % 11) * 256, 0}; }
  else if constexpr (EPI == EPI_GU) { return (Tile){D, 0, mtile_row0(t / 22, layer == 1), (t % 22) * 256, 0}; }
  else if constexpr (EPI == EPI_RES1) {
    if (t < 256) return (Tile){D, 0, mtile_row0(t >> 2, true), (t & 3) * 256, 0};
    int v = t - 256, tile = v >> 2; return (Tile){256, (v & 3) * 256, (tile >> 2) * S, (tile & 3) * 256, 1};
  } else {
    if (t < 256) return (Tile){DFF, 0, mtile_row0(t >> 2, true), (t & 3) * 256, 0};
    int v = t - 256, tile = v / 11; return (Tile){256, (v - tile * 11) * 256, (tile >> 2) * S, (tile & 3) * 256, 1};
  }
}

template <int EPI>
DI void gemm256(const Params& p, int layer, int tcur, bool prefetched, int tnext, char* shm) {
  const Tile tc = tile_of<EPI>(layer, tcur);
  const int K = tc.K, brow = tc.brow, bcol = tc.bcol;
  const bool atomic = tc.atomic != 0;
  constexpr int lda = (EPI == EPI_RES2) ? DFF : D, ldb = lda;
  const bf16_t* A0 = (const bf16_t*)(p.ws + (EPI == EPI_RES2 ? OFF_P : OFF_H));
  const bf16_t* Bt0 = (const bf16_t*)(p.ws + (EPI == EPI_IN ? OFF_WIN + (size_t)layer * NIN_ROWS * D * 2 : EPI == EPI_RES1 ? OFF_WOUT + (size_t)layer * D * D * 2
                                              : EPI == EPI_GU ? OFF_WGU + (size_t)layer * 2 * DFF * D * 2 : OFF_WD + (size_t)layer * D * DFF * 2));
  const bf16_t* A = A0 + tc.koff; const bf16_t* Bt = Bt0 + tc.koff;
  const int tid = otid();
  const int wid = tid >> 6, lane = tid & 63, wr = wid >> 2, wc = wid & 3, fr = lane & 15, fq = lane >> 4;
#define SA(b, h) (shm + ((b) * 2 + (h)) * HT_B)
#define SB(b, h) (shm + (4 + (b) * 2 + (h)) * HT_B)
  int sr0, sc0, sr1, sc1;
  stage_rc(tid * 16, sr0, sc0);
  stage_rc(tid * 16 + 8192, sr1, sc1);
  const unsigned oa0 = (unsigned)(sr0 * lda + sc0) * 2u, oa1 = (unsigned)(sr1 * lda + sc1) * 2u;
  const unsigned ob0 = (unsigned)(sr0 * ldb + sc0) * 2u, ob1 = (unsigned)(sr1 * ldb + sc1) * 2u;
#define STAGE_A(Pp, BASE, br, kt) do { const char* _gb = (const char*)((BASE) + (long)(br) * lda + (long)(kt) * 64);                 \
    unsigned _o0 = oa0, _o1 = oa1; asm volatile("" : "+v"(_o0), "+v"(_o1));                                                          \
    __builtin_amdgcn_global_load_lds((const unsigned*)(_gb + _o0), (unsigned*)((Pp) + tid * 16), 16, 0, 0);        \
    __builtin_amdgcn_global_load_lds((const unsigned*)(_gb + _o1), (unsigned*)((Pp) + tid * 16 + 8192), 16, 0, 0); } while (0)
#define STAGE_B(Pp, BASE, br, kt) do { const char* _gb = (const char*)((BASE) + (long)(br) * ldb + (long)(kt) * 64);                 \
    unsigned _o0 = ob0, _o1 = ob1; asm volatile("" : "+v"(_o0), "+v"(_o1));                                                          \
    __builtin_amdgcn_global_load_lds((const unsigned*)(_gb + _o0), (unsigned*)((Pp) + tid * 16), 16, 0, 0);        \
    __builtin_amdgcn_global_load_lds((const unsigned*)(_gb + _o1), (unsigned*)((Pp) + tid * 16 + 8192), 16, 0, 0); } while (0)
#define LDA(dst, b, h) _Pragma("unroll") for (int m = 0; m < 4; ++m) _Pragma("unroll") for (int k = 0; k < 2; ++k) \
    dst[m][k] = *reinterpret_cast<const bf16x8*>(SA(b, h) + lds_byte(wr * 64 + m * 16 + fr, k * 32 + fq * 8))
#define LDB(dst, b, h) _Pragma("unroll") for (int n = 0; n < 2; ++n) _Pragma("unroll") for (int k = 0; k < 2; ++k) \
    dst[n][k] = *reinterpret_cast<const bf16x8*>(SB(b, h) + lds_byte(wc * 32 + n * 16 + fr, k * 32 + fq * 8))
#define MMA(ai, bj, At_, Bt_) do { __builtin_amdgcn_s_setprio(1);                                                    \
    _Pragma("unroll") for (int m = 0; m < 4; ++m) _Pragma("unroll") for (int n = 0; n < 2; ++n) _Pragma("unroll") for (int k = 0; k < 2; ++k) \
      acc[ai][bj][m][n] = MFMA16(At_[m][k], Bt_[n][k], acc[ai][bj][m][n]);                                            \
    __builtin_amdgcn_s_setprio(0); } while (0)
#define WAIT_V(n) asm volatile("s_waitcnt vmcnt(" #n ")" ::: "memory")
#define WAIT_L(n) asm volatile("s_waitcnt lgkmcnt(" #n ")" ::: "memory")
#define BAR __builtin_amdgcn_s_barrier()
#define SCHED __builtin_amdgcn_sched_barrier(0)
  f32x4 acc[2][2][4][2];
#pragma unroll
  for (int a = 0; a < 2; ++a)
#pragma unroll
    for (int b = 0; b < 2; ++b)
#pragma unroll
      for (int m = 0; m < 4; ++m)
#pragma unroll
        for (int n = 0; n < 2; ++n) acc[a][b][m][n] = (f32x4){0.f, 0.f, 0.f, 0.f};
  bf16x8 At[4][2], B0[2][2], B1[2][2];
  const int nt = K / 64;
  if (!prefetched) {
    __syncthreads();
    STAGE_B(SB(0, 0), Bt, bcol, 0); STAGE_A(SA(0, 0), A, brow, 0);
    STAGE_B(SB(0, 1), Bt, bcol + 128, 0); STAGE_A(SA(0, 1), A, brow + 128, 0);
    if (wr == 1) BAR;
    WAIT_V(4); BAR;
    STAGE_B(SB(1, 0), Bt, bcol, 1); STAGE_A(SA(1, 0), A, brow, 1); STAGE_B(SB(1, 1), Bt, bcol + 128, 1);
    WAIT_V(6); BAR;
  } else {
    if (wr == 1) BAR;
    WAIT_V(0); BAR;
    BAR;
  }
  for (int t = 0; t < nt - 2; t += 2) {
    LDB(B0, 0, 0); SCHED; LDA(At, 0, 0); STAGE_A(SA(1, 1), A, brow + 128, t + 1);
    WAIT_L(8); BAR; WAIT_L(0); MMA(0, 0, At, B0); BAR; SCHED;
    LDB(B1, 0, 1); STAGE_B(SB(0, 0), Bt, bcol, t + 2);
    BAR; WAIT_L(0); MMA(0, 1, At, B1); BAR;
    LDA(At, 0, 1); STAGE_A(SA(0, 0), A, brow, t + 2);
    BAR; WAIT_L(0); MMA(1, 0, At, B0); BAR; SCHED;
    STAGE_B(SB(0, 1), Bt, bcol + 128, t + 2);
    WAIT_V(6); BAR; MMA(1, 1, At, B1); BAR;
    LDB(B0, 1, 0); SCHED; LDA(At, 1, 0); STAGE_A(SA(0, 1), A, brow + 128, t + 2);
    WAIT_L(8); BAR; WAIT_L(0); MMA(0, 0, At, B0); BAR; SCHED;
    LDB(B1, 1, 1); STAGE_B(SB(1, 0), Bt, bcol, t + 3);
    BAR; WAIT_L(0); MMA(0, 1, At, B1); BAR;
    LDA(At, 1, 1); STAGE_A(SA(1, 0), A, brow, t + 3);
    BAR; WAIT_L(0); MMA(1, 0, At, B0); BAR; SCHED;
    STAGE_B(SB(1, 1), Bt, bcol + 128, t + 3);
    WAIT_V(6); BAR; MMA(1, 1, At, B1); BAR;
  }
  { LDB(B0, 0, 0); LDA(At, 0, 0); STAGE_A(SA(1, 1), A, brow + 128, nt - 1);
    BAR; WAIT_L(0); MMA(0, 0, At, B0); BAR;
    LDB(B1, 0, 1); BAR; WAIT_L(0); MMA(0, 1, At, B1); BAR;
    LDA(At, 0, 1); WAIT_V(4); BAR; WAIT_L(0); MMA(1, 0, At, B0); MMA(1, 1, At, B1); BAR; }
  { LDB(B0, 1, 0); LDA(At, 1, 0); WAIT_V(2); BAR; WAIT_L(0); MMA(0, 0, At, B0); BAR;
    LDB(B1, 1, 1); WAIT_V(0); BAR; WAIT_L(0); MMA(0, 1, At, B1); BAR;
    LDA(At, 1, 1); BAR; WAIT_L(0); MMA(1, 0, At, B0); MMA(1, 1, At, B1); BAR; }
  if (wr == 0) BAR;
  if (tnext >= 0) {
    const Tile tn = tile_of<EPI>(layer, tnext);
    const bf16_t* An = A0 + tn.koff; const bf16_t* Bn = Bt0 + tn.koff;
    SCHED; STAGE_B(SB(0, 0), Bn, tn.bcol, 0); SCHED; STAGE_A(SA(0, 0), An, tn.brow, 0); SCHED;
    STAGE_B(SB(0, 1), Bn, tn.bcol + 128, 0); SCHED; STAGE_A(SA(0, 1), An, tn.brow + 128, 0); SCHED;
    STAGE_B(SB(1, 0), Bn, tn.bcol, 1); SCHED; STAGE_A(SA(1, 0), An, tn.brow, 1); SCHED; STAGE_B(SB(1, 1), Bn, tn.bcol + 128, 1); SCHED;
  }
#undef SA
#undef SB
#undef STAGE_A
#undef STAGE_B
#undef LDA
#undef LDB
#undef MMA
#undef WAIT_V
#undef WAIT_L
#undef BAR
#undef SCHED

  const int tid_e = otid();
  const int wr_e = tid_e >> 8, wc_e = (tid_e >> 6) & 3, fr_e = tid_e & 15, fq_e = (tid_e >> 4) & 3;
#define wr wr_e
#define wc wc_e
#define fr fr_e
#define fq fq_e
  if constexpr (EPI == EPI_IN) {
    bf16_t* P = (bf16_t*)(p.ws + OFF_P);
    bf16_t* VT = (bf16_t*)(p.ws + OFF_VT);
    const float2* ROPE = (const float2*)(p.ws + OFF_ROPE);
#pragma unroll
    for (int bj = 0; bj < 2; ++bj) {
      const int cg = (bcol + bj * 128 + wc * 32) >> 5;
      int cat, pcol0 = 0, hv = 0;
      float scale = 1.f;
      if (cg < 8) { cat = 0; pcol0 = cg * 32; scale = 0.125f; }
      else if (cg < 16) { cat = 0; pcol0 = cg * 32; }
      else if (cg < 24) { cat = 1; hv = (cg - 16) >> 1; }
      else if (cg < 32) { cat = 0; pcol0 = cg * 32 - 256; }
      else if (cg < 44) { cat = 0; pcol0 = cg * 32 - 256; scale = QSCALE; }
      else if (cg < 56) { cat = 0; pcol0 = cg * 32 - 256; }
      else if (cg < 68) { cat = 1; hv = 4 + ((cg - 56) >> 1); }
      else if (cg < 80) { cat = 3; pcol0 = 1536 + ((cg - 68) >> 1) * 64 + (cg & 1) * 16; scale = QSCALE; }
      else if (cg < 84) { cat = 3; pcol0 = 1920 + ((cg - 80) >> 1) * 64 + (cg & 1) * 16; }
      else { cat = 1; hv = 10 + ((cg - 84) >> 1); }
#pragma unroll
      for (int ai = 0; ai < 2; ++ai)
#pragma unroll
        for (int m = 0; m < 4; ++m) {
          const int row0 = brow + ai * 128 + wr * 64 + m * 16 + fq * 4;
          const int b = row0 / S, pos0 = row0 - b * S;
          if (cat == 0) {
#pragma unroll
            for (int n = 0; n < 2; ++n)
#pragma unroll
              for (int j = 0; j < 4; ++j) P[(size_t)(row0 + j) * PW + pcol0 + n * 16 + fr] = f2bf(acc[ai][bj][m][n][j] * scale);
          } else if (cat == 3) {
#pragma unroll
            for (int j = 0; j < 4; ++j) {
              float a1 = acc[ai][bj][m][0][j], a2 = acc[ai][bj][m][1][j];
              float o1 = a1, o2 = a2;
              if (pos0 >= L) {
                float2 cs = ROPE[(size_t)(pos0 + j - L) * 32 + (cg & 1) * 16 + fr];
                o1 = a1 * cs.x - a2 * cs.y; o2 = a1 * cs.y + a2 * cs.x;
              }
              P[(size_t)(row0 + j) * PW + pcol0 + fr] = f2bf(o1 * scale);
              P[(size_t)(row0 + j) * PW + pcol0 + fr + 32] = f2bf(o2 * scale);
            }
          } else {
#pragma unroll
            for (int n = 0; n < 2; ++n) {
              uint2 o; o.x = pack2(acc[ai][bj][m][n][0], acc[ai][bj][m][n][1]); o.y = pack2(acc[ai][bj][m][n][2], acc[ai][bj][m][n][3]);
              *(uint2*)(VT + ((size_t)(b * 12 + hv) * 64 + (cg & 1) * 32 + n * 16 + fr) * S + pos0) = o;
            }
          }
        }
    }
  } else if constexpr (EPI == EPI_RES1 || EPI == EPI_RES2) {
    const float* MOD = (const float*)(p.ws + OFF_MOD);
    const int bq = brow / S, mv = (brow - bq * S) < L ? 4 : bq;
    const float* gate = MOD + (size_t)(layer * 5 + mv) * 6144 + (EPI == EPI_RES1 ? 2048 : 5120) + bcol + wc * 32 + fr;
    float gv[2][2];
#pragma unroll
    for (int bj = 0; bj < 2; ++bj)
#pragma unroll
      for (int n = 0; n < 2; ++n) gv[bj][n] = gate[bj * 128 + n * 16];
    float* xbase = xrow(p, brow) + bcol + wc * 32 + fr;
    if (atomic) {
      const int sl = tc.koff >> 8;
      float* sb = (EPI == EPI_RES1 ? (float*)(p.ws + OFF_SLF) + (size_t)sl * NB * L * D : slab_i(p, sl)) + (size_t)bq * L * D + bcol + wc * 32 + fr;
#pragma unroll
      for (int ai = 0; ai < 2; ++ai)
#pragma unroll
        for (int m = 0; m < 4; ++m)
#pragma unroll
          for (int j = 0; j < 4; ++j) {
            float* xr = sb + (size_t)(ai * 128 + wr * 64 + m * 16 + fq * 4 + j) * D;
#pragma unroll
            for (int bj = 0; bj < 2; ++bj)
#pragma unroll
              for (int n = 0; n < 2; ++n) xr[bj * 128 + n * 16] = gv[bj][n] * acc[ai][bj][m][n][j];
          }
    } else {
#pragma unroll
      for (int ai = 0; ai < 2; ++ai)
#pragma unroll
        for (int m = 0; m < 4; ++m)
#pragma unroll
          for (int j = 0; j < 4; ++j) {
            float* xr = xbase + (size_t)(ai * 128 + wr * 64 + m * 16 + fq * 4 + j) * D;
#pragma unroll
            for (int bj = 0; bj < 2; ++bj)
#pragma unroll
              for (int n = 0; n < 2; ++n) xr[bj * 128 + n * 16] += gv[bj][n] * acc[ai][bj][m][n][j];
          }
    }
  } else {
    bf16_t* ACT = (bf16_t*)(p.ws + OFF_P);
#pragma unroll
    for (int bj = 0; bj < 2; ++bj) {
      const int cg = (bcol + bj * 128 + wc * 32) >> 5;
#pragma unroll
      for (int ai = 0; ai < 2; ++ai)
#pragma unroll
        for (int m = 0; m < 4; ++m) {
          const int row0 = brow + ai * 128 + wr * 64 + m * 16 + fq * 4;
#pragma unroll
          for (int j = 0; j < 4; ++j) {
            float gv = acc[ai][bj][m][0][j], uv = acc[ai][bj][m][1][j];
            ACT[(size_t)(row0 + j) * DFF + cg * 16 + fr] = f2bf(silu_f(gv) * uv);
          }
        }
    }
  }
}

#undef wr
#undef wc
#undef fr
#undef fq

DI void za_item(const Params& p, int layer, int item, char* smem) {
  const int tid = otid(), lane = tid & 63, w = tid >> 6, l15 = lane & 15, g = lane >> 4;
  const bf16_t* H = (const bf16_t*)(p.ws + OFF_H);
  const bf16_t* W = (const bf16_t*)(p.ws + OFF_WIN) + ((size_t)layer * NIN_ROWS + NIN) * D;
  float* ZA = (float*)(p.ws + OFF_ZA);
  float* sZ = (float*)smem;
  const int row0 = item * 64 + (w & 3) * 16, kh = (w >> 2) * 512;
  const bf16_t* ap = H + (size_t)(row0 + l15) * D + kh + g * 8;
  const bf16_t* b0p = W + (size_t)l15 * D + kh + g * 8;
  const bf16_t* b1p = W + (size_t)(16 + l15) * D + kh + g * 8;
  f32x4 c0 = (f32x4){0.f, 0.f, 0.f, 0.f}, c1 = (f32x4){0.f, 0.f, 0.f, 0.f};
#pragma unroll
  for (int hb = 0; hb < 2; ++hb) {
    bf16x8 a[8], b0[8], b1[8];
#pragma unroll
    for (int k = 0; k < 8; ++k) { a[k] = *(const bf16x8*)(ap + (hb * 8 + k) * 32); b0[k] = *(const bf16x8*)(b0p + (hb * 8 + k) * 32); b1[k] = *(const bf16x8*)(b1p + (hb * 8 + k) * 32); }
#pragma unroll
    for (int k = 0; k < 8; ++k) { c0 = MFMA16(a[k], b0[k], c0); c1 = MFMA16(a[k], b1[k], c1); }
  }
  __syncthreads();
  if (w >= 4) { *(f32x4*)(sZ + (((w & 3) * 2 + 0) * 64 + lane) * 4) = c0; *(f32x4*)(sZ + (((w & 3) * 2 + 1) * 64 + lane) * 4) = c1; }
  __syncthreads();
  if (w < 4) {
    c0 += *(const f32x4*)(sZ + ((w * 2 + 0) * 64 + lane) * 4);
    c1 += *(const f32x4*)(sZ + ((w * 2 + 1) * 64 + lane) * 4);
#pragma unroll
    for (int j = 0; j < 4; ++j) {
      ZA[(size_t)(row0 + g * 4 + j) * 32 + l15] = c0[j];
      ZA[(size_t)(row0 + g * 4 + j) * 32 + 16 + l15] = c1[j];
    }
  }
}

DI void attn_item(const Params& p, int layer, int kind, int b, int h, int qt, char* smem) {
  char* sK = smem;
  char* sV = smem + 16384;
  float* sBias = (float*)(smem + 32768);
  const bf16_t* P = (const bf16_t*)(p.ws + OFF_P);
  const bf16_t* VT = (const bf16_t*)(p.ws + OFF_VT);
  bf16_t* Y = (bf16_t*)(p.ws + OFF_H);
  const int tid = otid(), lane = tid & 63, w = tid >> 6, l15 = lane & 15, g = lane >> 4;
  const bool is_swa = (kind == 0 || kind == 2), is_ctxq = kind >= 2;
  const int qcol = is_swa ? 1536 + h * 64 : 768 + h * 64;
  const int kcol = is_swa ? 1920 + (h / 3) * 64 : 1152 + h * 64;
  const int hv = is_swa ? 10 + h / 3 : 4 + h;
  const int ycol = is_swa ? 640 + h * 64 : 256 + h * 64;
  const int qpos0 = is_ctxq ? qt * 128 : L + qt * 128;
  const size_t rowbase = (size_t)b * S;
  int lt0 = 0, nlt = 0, rs_q = 0;
  const int rq = 2 * qt + (w >> 2);
  if (kind == 0) { int lo = qt * 128 - 128, hi = qt * 128 + 256; lo = lo < 0 ? 0 : lo; hi = hi > T ? T : hi; lt0 = L + lo; nlt = (hi - lo) >> 6; }
  else if (kind == 1) {
    int r0 = 2 * qt, rs0 = r0 - 4, rs1 = r0 - 3;
    rs0 = rs0 < 0 ? 0 : (rs0 > 56 ? 56 : rs0); rs1 = rs1 < 0 ? 0 : (rs1 > 56 ? 56 : rs1);
    lt0 = L + rs0 * 64; nlt = rs1 - rs0 + 8;
    rs_q = rq - 4; rs_q = rs_q < 0 ? 0 : (rs_q > 56 ? 56 : rs_q);
  }
  const int ntiles = 4 + nlt;
  const int lr = tid >> 3, c8 = tid & 7;
  const bf16_t* kbase = P + (rowbase + lr) * PW + kcol + c8 * 8;
  const bf16_t* vbase = VT + ((size_t)(b * 12 + hv) * 64 + lr) * S + c8 * 8;
  const int wofs = lds_byte(lr, c8 * 8);
  const int krow_l = 8 * (l15 >> 2) + (l15 & 3);
  const int kofs0 = lds_byte(krow_l, g * 8), kofs1 = lds_byte(krow_l + 4, g * 8);
  const int vofs = lds_byte(l15, g * 8);
  u32x4 kr = *(const u32x4*)(kbase), vr = *(const u32x4*)(vbase);
  __syncthreads();
  if (kind == 1 && tid < 480) { int dr = tid >> 5, dc = tid & 31; sBias[tid] = dc < 31 ? p.na_rpb[(size_t)(layer * 6 + h) * 465 + dr * 31 + dc] * LOG2E : -INFINITY; }
  *(u32x4*)(sK + wofs) = kr; *(u32x4*)(sV + wofs) = vr;
  kr = *(const u32x4*)(kbase + (size_t)64 * PW); vr = *(const u32x4*)(vbase + 64);
  const bf16_t* qp = P + (rowbase + qpos0 + w * 16 + l15) * PW + qcol + g * 8;
  const bf16x8 aq0 = *(const bf16x8*)qp, aq1 = *(const bf16x8*)(qp + 32);
  f32x4 o[4];
#pragma unroll
  for (int i = 0; i < 4; ++i) o[i] = (f32x4){0.f, 0.f, 0.f, 0.f};
  float m = -1e30f, ls = 0.f;
  const int tq = qt * 128 + w * 16 + l15;
  const int tq0 = qt * 128 + w * 16;
  int boff[16];
  {
    const int qi = (w & 3) * 16 + l15;
    int wsr = qi - 8; wsr = wsr < 0 ? 0 : (wsr > 48 ? 48 : wsr);
#pragma unroll
    for (int nt = 0; nt < 4; ++nt)
#pragma unroll
      for (int j = 0; j < 4; ++j) {
        int kk = 32 * (nt >> 1) + 8 * g + 4 * (nt & 1) + j;
        bool valid = (kk >= wsr) && (kk < wsr + 16);
        boff[nt * 4 + j] = valid ? kk - qi + 15 : 31;
      }
  }
  __syncthreads();
  for (int it = 0; it < ntiles; ++it) {
    const int cur = it & 1;
    const int pos0 = it < 4 ? it * 64 : lt0 + (it - 4) * 64;
    if (it + 1 < ntiles) {
      *(u32x4*)(sK + (cur ^ 1) * 8192 + wofs) = kr; *(u32x4*)(sV + (cur ^ 1) * 8192 + wofs) = vr;
      if (it + 2 < ntiles) {
        const int np0 = (it + 2) < 4 ? (it + 2) * 64 : lt0 + (it + 2 - 4) * 64;
        kr = *(const u32x4*)(kbase + (size_t)np0 * PW); vr = *(const u32x4*)(vbase + np0);
      }
    }
    bool skip = false, needmask = false;
    int krow = 0;
    if (it >= 4) {
      if (kind == 0) {
        const int tk0 = pos0 - L;
        skip = (tq0 - (tk0 + 63) > 128) || (tk0 - (tq0 + 15) > 128);
        needmask = !((tq0 + 15 - tk0 <= 128) && (tk0 + 63 - tq0 <= 128));
      } else {
        krow = (pos0 - L) >> 6;
        skip = !((krow >= rs_q) && (krow < rs_q + 8));
        needmask = true;
      }
    }
    if (!skip) {
      const char* kb = sK + cur * 8192;
      const char* vb = sV + cur * 8192 + vofs;
      f32x4 s[4];
#pragma unroll
      for (int ks = 0; ks < 2; ++ks) {
        bf16x8 k00 = *(const bf16x8*)(kb + kofs0 + ks * 4096), k01 = *(const bf16x8*)(kb + kofs0 + ks * 4096 + 1024);
        bf16x8 k10 = *(const bf16x8*)(kb + kofs1 + ks * 4096), k11 = *(const bf16x8*)(kb + kofs1 + ks * 4096 + 1024);
        s[2 * ks] = MFMA16(k00, aq0, ((f32x4){0.f, 0.f, 0.f, 0.f}));
        s[2 * ks] = MFMA16(k01, aq1, s[2 * ks]);
        s[2 * ks + 1] = MFMA16(k10, aq0, ((f32x4){0.f, 0.f, 0.f, 0.f}));
        s[2 * ks + 1] = MFMA16(k11, aq1, s[2 * ks + 1]);
      }
      if (needmask) {
        if (kind == 0) {
          const int tk0 = pos0 - L;
#pragma unroll
          for (int nt = 0; nt < 4; ++nt)
#pragma unroll
            for (int j = 0; j < 4; ++j) {
              int df = tq - (tk0 + 32 * (nt >> 1) + 8 * g + 4 * (nt & 1) + j); df = df < 0 ? -df : df;
              if (df > 128) s[nt][j] = -INFINITY;
            }
        } else {
          const float* brow = sBias + (krow - rq + 7) * 32;
#pragma unroll
          for (int nt = 0; nt < 4; ++nt)
#pragma unroll
            for (int j = 0; j < 4; ++j) s[nt][j] += brow[boff[nt * 4 + j]];
        }
      }
      float mx = fmaxf(fmaxf(fmaxf(s[0][0], s[0][1]), fmaxf(s[0][2], s[0][3])), fmaxf(fmaxf(s[1][0], s[1][1]), fmaxf(s[1][2], s[1][3])));
      mx = fmaxf(mx, fmaxf(fmaxf(fmaxf(s[2][0], s[2][1]), fmaxf(s[2][2], s[2][3])), fmaxf(fmaxf(s[3][0], s[3][1]), fmaxf(s[3][2], s[3][3]))));
      mx = fmaxf(mx, xor_lane(mx, lane, 16));
      mx = fmaxf(mx, xor_lane(mx, lane, 32));
      if (__builtin_amdgcn_ballot_w64(mx > m + 8.f) != 0ull) {
        const float mn = fmaxf(m, mx);
        const float alpha = __builtin_amdgcn_exp2f(m - mn);
        m = mn;
        ls *= alpha;
#pragma unroll
        for (int et = 0; et < 4; ++et) { o[et][0] *= alpha; o[et][1] *= alpha; o[et][2] *= alpha; o[et][3] *= alpha; }
      }
      float psum = 0.f;
#pragma unroll
      for (int nt = 0; nt < 4; ++nt)
#pragma unroll
        for (int j = 0; j < 4; ++j) { float pv = __builtin_amdgcn_exp2f(s[nt][j] - m); s[nt][j] = pv; psum += pv; }
      ls += psum;
#pragma unroll
      for (int ks = 0; ks < 2; ++ks) {
        u32x4 pk; pk.x = pack2(s[2 * ks][0], s[2 * ks][1]); pk.y = pack2(s[2 * ks][2], s[2 * ks][3]);
        pk.z = pack2(s[2 * ks + 1][0], s[2 * ks + 1][1]); pk.w = pack2(s[2 * ks + 1][2], s[2 * ks + 1][3]);
        const bf16x8 pb = __builtin_bit_cast(bf16x8, pk);
#pragma unroll
        for (int et = 0; et < 4; ++et) {
          bf16x8 vf = *(const bf16x8*)(vb + et * 2048 + ks * 1024);
          o[et] = MFMA16(vf, pb, o[et]);
        }
      }
    }
    __syncthreads();
  }
  ls += xor_lane(ls, lane, 16);
  ls += xor_lane(ls, lane, 32);
  float f;
  if (is_swa) {
    const float sink = p.swa_sink[layer * 6 + h] * LOG2E;
    float M = fmaxf(m, sink);
    float a = __builtin_amdgcn_exp2f(m - M);
    f = a / (ls * a + __builtin_amdgcn_exp2f(sink - M));
  } else {
    f = 1.f / ls;
  }
  bf16_t* yp = Y + (rowbase + qpos0 + w * 16 + l15) * D + ycol + g * 4;
#pragma unroll
  for (int et = 0; et < 4; ++et) {
    uint2 ov; ov.x = pack2(o[et][0] * f, o[et][1] * f); ov.y = pack2(o[et][2] * f, o[et][3] * f);
    *(uint2*)(yp + et * 16) = ov;
  }
}

DI void na2_item(const Params& p, int layer, int b, int h, int qt, char* smem) {
  char* sK = smem;
  char* sV = smem + 32768;
  float* sBias = (float*)(smem + 65536);
  const bf16_t* P = (const bf16_t*)(p.ws + OFF_P);
  const bf16_t* VT = (const bf16_t*)(p.ws + OFF_VT);
  bf16_t* Y = (bf16_t*)(p.ws + OFF_H);
  const int tid = otid(), lane = tid & 63, w = tid >> 6, l15 = lane & 15, g = lane >> 4;
  const int qcol = 768 + h * 64, kcol = 1152 + h * 64, hv = 4 + h, ycol = 256 + h * 64;
  const size_t rowbase = (size_t)b * S;
  const int rq = 2 * qt + (w >> 2), c0 = 16 * (w & 3);
  int rs0 = 2 * qt - 4, rs1 = 2 * qt - 3, rs_q = rq - 4;
  rs0 = rs0 < 0 ? 0 : (rs0 > 56 ? 56 : rs0); rs1 = rs1 < 0 ? 0 : (rs1 > 56 ? 56 : rs1); rs_q = rs_q < 0 ? 0 : (rs_q > 56 ? 56 : rs_q);
  const int npair = (rs1 - rs0 + 9) >> 1, ntiles = 4 + npair;
  int kc0 = c0 - 8; kc0 = kc0 < 0 ? 0 : (kc0 > 32 ? 32 : kc0);
  const int lr = tid >> 3, c8 = tid & 7;
  const bf16_t* kbase = P + (rowbase + lr) * PW + kcol + c8 * 8;
  const bf16_t* vbase = VT + ((size_t)(b * 12 + hv) * 64 + lr) * S + c8 * 8;
  const int wofs = lds_byte(lr, c8 * 8);
  const int kl = 8 * (l15 >> 2) + (l15 & 3);
  const int kofs0 = lds_byte(kl, g * 8), kofs1 = lds_byte(kl + 4, g * 8);
  const int lk0 = lds_byte(kc0 + kl, g * 8), lk1 = lds_byte(kc0 + kl + 4, g * 8);
  const int vofs = lds_byte(l15, g * 8);
  const int lvofs = lds_byte(l15, kc0 + g * 8);
  auto pos_of = [&](int it, int r) -> int { if (it < 4) return 64 * it; int kr_ = rs0 + 2 * (it - 4) + r; kr_ = kr_ > 63 ? 63 : kr_; return L + kr_ * 64; };
  u32x4 kr0 = *(const u32x4*)(kbase), vr0 = *(const u32x4*)(vbase), kr1, vr1;
  kr1 = kr0; vr1 = vr0;
  __syncthreads();
  if (tid < 480) { int dr = tid >> 5, dc = tid & 31; sBias[tid] = dc < 31 ? p.na_rpb[(size_t)(layer * 6 + h) * 465 + dr * 31 + dc] * LOG2E : -INFINITY; }
  *(u32x4*)(sK + wofs) = kr0; *(u32x4*)(sV + wofs) = vr0;
  kr0 = *(const u32x4*)(kbase + (size_t)64 * PW); vr0 = *(const u32x4*)(vbase + 64);
  const bf16_t* qp = P + (rowbase + L + rq * 64 + c0 + l15) * PW + qcol + g * 8;
  const bf16x8 aq0 = *(const bf16x8*)qp, aq1 = *(const bf16x8*)(qp + 32);
  f32x4 o[4];
#pragma unroll
  for (int i = 0; i < 4; ++i) o[i] = (f32x4){0.f, 0.f, 0.f, 0.f};
  float m = -1e30f, ls = 0.f;
  int boff[8];
  {
    const int qi = c0 + l15;
    int wsr = qi - 8; wsr = wsr < 0 ? 0 : (wsr > 48 ? 48 : wsr);
#pragma unroll
    for (int hh = 0; hh < 2; ++hh)
#pragma unroll
      for (int j = 0; j < 4; ++j) {
        int kk = kc0 + 8 * g + 4 * hh + j;
        boff[hh * 4 + j] = ((kk >= wsr) && (kk < wsr + 16)) ? kk - qi + 15 : 31;
      }
  }
  __syncthreads();
  for (int it = 0; it < ntiles; ++it) {
    const int cur = it & 1;
    if (it + 1 < ntiles) {
      char* dk = sK + (cur ^ 1) * 16384 + wofs; char* dv = sV + (cur ^ 1) * 16384 + wofs;
      *(u32x4*)dk = kr0; *(u32x4*)dv = vr0;
      if (it + 1 >= 4) { *(u32x4*)(dk + 8192) = kr1; *(u32x4*)(dv + 8192) = vr1; }
      if (it + 2 < ntiles) {
        const int pa = pos_of(it + 2, 0);
        kr0 = *(const u32x4*)(kbase + (size_t)pa * PW); vr0 = *(const u32x4*)(vbase + pa);
        if (it + 2 >= 4) { const int pb_ = pos_of(it + 2, 1); kr1 = *(const u32x4*)(kbase + (size_t)pb_ * PW); vr1 = *(const u32x4*)(vbase + pb_); }
      }
    }
    const char* kb = sK + cur * 16384;
    const char* vb = sV + cur * 16384;
    f32x4 s[4];
    bool act0 = true, act1 = true;
    if (it < 4) {
#pragma unroll
      for (int ks = 0; ks < 2; ++ks) {
        bf16x8 k00 = *(const bf16x8*)(kb + kofs0 + ks * 4096), k01 = *(const bf16x8*)(kb + kofs0 + ks * 4096 + 1024);
        bf16x8 k10 = *(const bf16x8*)(kb + kofs1 + ks * 4096), k11 = *(const bf16x8*)(kb + kofs1 + ks * 4096 + 1024);
        s[2 * ks] = MFMA16(k00, aq0, ((f32x4){0.f, 0.f, 0.f, 0.f}));
        s[2 * ks] = MFMA16(k01, aq1, s[2 * ks]);
        s[2 * ks + 1] = MFMA16(k10, aq0, ((f32x4){0.f, 0.f, 0.f, 0.f}));
        s[2 * ks + 1] = MFMA16(k11, aq1, s[2 * ks + 1]);
      }
    } else {
      const int krA = rs0 + 2 * (it - 4);
      act0 = (krA >= rs_q) && (krA < rs_q + 8);
      act1 = (krA + 1 >= rs_q) && (krA + 1 < rs_q + 8);
#pragma unroll
      for (int ks = 0; ks < 2; ++ks) {
        const bool act = ks == 0 ? act0 : act1;
        if (act) {
          const char* kbr = kb + ks * 8192;
          bf16x8 k00 = *(const bf16x8*)(kbr + lk0), k01 = *(const bf16x8*)(kbr + lk0 + 1024);
          bf16x8 k10 = *(const bf16x8*)(kbr + lk1), k11 = *(const bf16x8*)(kbr + lk1 + 1024);
          s[2 * ks] = MFMA16(k00, aq0, ((f32x4){0.f, 0.f, 0.f, 0.f}));
          s[2 * ks] = MFMA16(k01, aq1, s[2 * ks]);
          s[2 * ks + 1] = MFMA16(k10, aq0, ((f32x4){0.f, 0.f, 0.f, 0.f}));
          s[2 * ks + 1] = MFMA16(k11, aq1, s[2 * ks + 1]);
          const float* brow = sBias + (krA + ks - rq + 7) * 32;
#pragma unroll
          for (int hh = 0; hh < 2; ++hh)
#pragma unroll
            for (int j = 0; j < 4; ++j) s[2 * ks + hh][j] += brow[boff[hh * 4 + j]];
        } else {
          s[2 * ks] = (f32x4){-INFINITY, -INFINITY, -INFINITY, -INFINITY};
          s[2 * ks + 1] = s[2 * ks];
        }
      }
    }
    if (act0 || act1) {
      float mx = fmaxf(fmaxf(fmaxf(s[0][0], s[0][1]), fmaxf(s[0][2], s[0][3])), fmaxf(fmaxf(s[1][0], s[1][1]), fmaxf(s[1][2], s[1][3])));
      mx = fmaxf(mx, fmaxf(fmaxf(fmaxf(s[2][0], s[2][1]), fmaxf(s[2][2], s[2][3])), fmaxf(fmaxf(s[3][0], s[3][1]), fmaxf(s[3][2], s[3][3]))));
      mx = fmaxf(mx, xor_lane(mx, lane, 16));
      mx = fmaxf(mx, xor_lane(mx, lane, 32));
      if (__builtin_amdgcn_ballot_w64(mx > m + 8.f) != 0ull) {
        const float mn = fmaxf(m, mx);
        const float alpha = __builtin_amdgcn_exp2f(m - mn);
        m = mn;
        ls *= alpha;
#pragma unroll
        for (int et = 0; et < 4; ++et) { o[et][0] *= alpha; o[et][1] *= alpha; o[et][2] *= alpha; o[et][3] *= alpha; }
      }
      float psum = 0.f;
#pragma unroll
      for (int nt = 0; nt < 4; ++nt)
#pragma unroll
        for (int j = 0; j < 4; ++j) { float pv = __builtin_amdgcn_exp2f(s[nt][j] - m); s[nt][j] = pv; psum += pv; }
      ls += psum;
#pragma unroll
      for (int ks = 0; ks < 2; ++ks) {
        const bool act = ks == 0 ? act0 : act1;
        if (act) {
          u32x4 pk; pk.x = pack2(s[2 * ks][0], s[2 * ks][1]); pk.y = pack2(s[2 * ks][2], s[2 * ks][3]);
          pk.z = pack2(s[2 * ks + 1][0], s[2 * ks + 1][1]); pk.w = pack2(s[2 * ks + 1][2], s[2 * ks + 1][3]);
          const bf16x8 pb = __builtin_bit_cast(bf16x8, pk);
          const char* vp = it < 4 ? vb + vofs + ks * 1024 : vb + ks * 8192 + lvofs;
#pragma unroll
          for (int et = 0; et < 4; ++et) {
            bf16x8 vf = *(const bf16x8*)(vp + et * 2048);
            o[et] = MFMA16(vf, pb, o[et]);
          }
        }
      }
    }
    __syncthreads();
  }
  ls += xor_lane(ls, lane, 16);
  ls += xor_lane(ls, lane, 32);
  const float f = 1.f / ls;
  bf16_t* yp = Y + (rowbase + L + rq * 64 + c0 + l15) * D + ycol + g * 4;
#pragma unroll
  for (int et = 0; et < 4; ++et) {
    uint2 ov; ov.x = pack2(o[et][0] * f, o[et][1] * f); ov.y = pack2(o[et][2] * f, o[et][3] * f);
    *(uint2*)(yp + et * 16) = ov;
  }
}

DI void swa3_item(const Params& p, int layer, int b, int kvh, int qt, char* smem) {
  char* sK = smem;
  char* sV = smem + 16384;
  const bf16_t* P = (const bf16_t*)(p.ws + OFF_P);
  const bf16_t* VT = (const bf16_t*)(p.ws + OFF_VT);
  bf16_t* Y = (bf16_t*)(p.ws + OFF_H);
  const int tid = otid(), lane = tid & 63, w = tid >> 6, l15 = lane & 15, g = lane >> 4;
  const int kcol = 1920 + kvh * 64, hv = 10 + kvh;
  const int qpos0 = L + qt * 128;
  const size_t rowbase = (size_t)b * S;
  int lo = qt * 128 - 128, hi = qt * 128 + 256; lo = lo < 0 ? 0 : lo; hi = hi > T ? T : hi;
  const int lt0 = L + lo, ntiles = 4 + ((hi - lo) >> 6);
  const int lr = tid >> 3, c8 = tid & 7;
  const bf16_t* kbase = P + (rowbase + lr) * PW + kcol + c8 * 8;
  const bf16_t* vbase = VT + ((size_t)(b * 12 + hv) * 64 + lr) * S + c8 * 8;
  const int wofs = lds_byte(lr, c8 * 8);
  const int krow_l = 8 * (l15 >> 2) + (l15 & 3);
  const int kofs0 = lds_byte(krow_l, g * 8), kofs1 = lds_byte(krow_l + 4, g * 8);
  const int vofs = lds_byte(l15, g * 8);
  u32x4 kr = *(const u32x4*)(kbase), vr = *(const u32x4*)(vbase);
  __syncthreads();
  *(u32x4*)(sK + wofs) = kr; *(u32x4*)(sV + wofs) = vr;
  kr = *(const u32x4*)(kbase + (size_t)64 * PW); vr = *(const u32x4*)(vbase + 64);
  bf16x8 aq[3][2];
#pragma unroll
  for (int hd = 0; hd < 3; ++hd) {
    const bf16_t* qp = P + (rowbase + qpos0 + w * 16 + l15) * PW + 1536 + (kvh * 3 + hd) * 64 + g * 8;
    aq[hd][0] = *(const bf16x8*)qp; aq[hd][1] = *(const bf16x8*)(qp + 32);
  }
  f32x4 o[3][4];
  float m[3], ls[3];
  float minit = -1e30f; asm volatile("" : "+v"(minit));
#pragma unroll
  for (int hd = 0; hd < 3; ++hd) {
    m[hd] = minit; ls[hd] = 0.f;
#pragma unroll
    for (int i = 0; i < 4; ++i) o[hd][i] = (f32x4){0.f, 0.f, 0.f, 0.f};
  }
  const int tq = qt * 128 + w * 16 + l15;
  const int tq0 = qt * 128 + w * 16;
  __syncthreads();
  for (int it = 0; it < ntiles; ++it) {
    const int cur = it & 1;
    const int pos0 = it < 4 ? it * 64 : lt0 + (it - 4) * 64;
    if (it + 1 < ntiles) {
      *(u32x4*)(sK + (cur ^ 1) * 8192 + wofs) = kr; *(u32x4*)(sV + (cur ^ 1) * 8192 + wofs) = vr;
      if (it + 2 < ntiles) {
        const int np0 = (it + 2) < 4 ? (it + 2) * 64 : lt0 + (it + 2 - 4) * 64;
        kr = *(const u32x4*)(kbase + (size_t)np0 * PW); vr = *(const u32x4*)(vbase + np0);
      }
    }
    bool skip = false, needmask = false;
    const int tk0 = pos0 - L;
    if (it >= 4) {
      skip = (tq0 - (tk0 + 63) > 128) || (tk0 - (tq0 + 15) > 128);
      needmask = !((tq0 + 15 - tk0 <= 128) && (tk0 + 63 - tq0 <= 128));
    }
    if (!skip) {
      const char* kb = sK + cur * 8192;
      const char* vb = sV + cur * 8192 + vofs;
      f32x4 s[3][4];
#pragma unroll
      for (int ks = 0; ks < 2; ++ks) {
        const bf16x8 k00 = *(const bf16x8*)(kb + kofs0 + ks * 4096), k01 = *(const bf16x8*)(kb + kofs0 + ks * 4096 + 1024);
        const bf16x8 k10 = *(const bf16x8*)(kb + kofs1 + ks * 4096), k11 = *(const bf16x8*)(kb + kofs1 + ks * 4096 + 1024);
#pragma unroll
        for (int hd = 0; hd < 3; ++hd) {
          s[hd][2 * ks] = MFMA16(k00, aq[hd][0], ((f32x4){0.f, 0.f, 0.f, 0.f}));
          s[hd][2 * ks] = MFMA16(k01, aq[hd][1], s[hd][2 * ks]);
          s[hd][2 * ks + 1] = MFMA16(k10, aq[hd][0], ((f32x4){0.f, 0.f, 0.f, 0.f}));
          s[hd][2 * ks + 1] = MFMA16(k11, aq[hd][1], s[hd][2 * ks + 1]);
        }
      }
      if (needmask) {
#pragma unroll
        for (int nt = 0; nt < 4; ++nt)
#pragma unroll
          for (int j = 0; j < 4; ++j) {
            int df = tq - (tk0 + 32 * (nt >> 1) + 8 * g + 4 * (nt & 1) + j); df = df < 0 ? -df : df;
            if (df > 128) { s[0][nt][j] = -INFINITY; s[1][nt][j] = -INFINITY; s[2][nt][j] = -INFINITY; }
          }
      }
      bf16x8 pb[3][2];
#pragma unroll
      for (int hd = 0; hd < 3; ++hd) {
        float mx = fmaxf(fmaxf(fmaxf(s[hd][0][0], s[hd][0][1]), fmaxf(s[hd][0][2], s[hd][0][3])), fmaxf(fmaxf(s[hd][1][0], s[hd][1][1]), fmaxf(s[hd][1][2], s[hd][1][3])));
        mx = fmaxf(mx, fmaxf(fmaxf(fmaxf(s[hd][2][0], s[hd][2][1]), fmaxf(s[hd][2][2], s[hd][2][3])), fmaxf(fmaxf(s[hd][3][0], s[hd][3][1]), fmaxf(s[hd][3][2], s[hd][3][3]))));
        mx = fmaxf(mx, xor_lane(mx, lane, 16));
        mx = fmaxf(mx, xor_lane(mx, lane, 32));
        if (__builtin_amdgcn_ballot_w64(mx > m[hd] + 8.f) != 0ull) {
          const float mn = fmaxf(m[hd], mx);
          const float alpha = __builtin_amdgcn_exp2f(m[hd] - mn);
          m[hd] = mn;
          ls[hd] *= alpha;
#pragma unroll
          for (int et = 0; et < 4; ++et) { o[hd][et][0] *= alpha; o[hd][et][1] *= alpha; o[hd][et][2] *= alpha; o[hd][et][3] *= alpha; }
        }
        float psum = 0.f;
#pragma unroll
        for (int nt = 0; nt < 4; ++nt)
#pragma unroll
          for (int j = 0; j < 4; ++j) { float pv = __builtin_amdgcn_exp2f(s[hd][nt][j] - m[hd]); s[hd][nt][j] = pv; psum += pv; }
        ls[hd] += psum;
#pragma unroll
        for (int ks = 0; ks < 2; ++ks) {
          u32x4 pk; pk.x = pack2(s[hd][2 * ks][0], s[hd][2 * ks][1]); pk.y = pack2(s[hd][2 * ks][2], s[hd][2 * ks][3]);
          pk.z = pack2(s[hd][2 * ks + 1][0], s[hd][2 * ks + 1][1]); pk.w = pack2(s[hd][2 * ks + 1][2], s[hd][2 * ks + 1][3]);
          pb[hd][ks] = __builtin_bit_cast(bf16x8, pk);
        }
      }
#pragma unroll
      for (int ks = 0; ks < 2; ++ks)
#pragma unroll
        for (int et = 0; et < 4; ++et) {
          const bf16x8 vf = *(const bf16x8*)(vb + et * 2048 + ks * 1024);
#pragma unroll
          for (int hd = 0; hd < 3; ++hd) o[hd][et] = MFMA16(vf, pb[hd][ks], o[hd][et]);
        }
    }
    __syncthreads();
  }
#pragma unroll
  for (int hd = 0; hd < 3; ++hd) {
    const int hq = kvh * 3 + hd;
    float l = ls[hd];
    l += xor_lane(l, lane, 16);
    l += xor_lane(l, lane, 32);
    const float sink = p.swa_sink[layer * 6 + hq] * LOG2E;
    const float M = fmaxf(m[hd], sink);
    const float a = __builtin_amdgcn_exp2f(m[hd] - M);
    const float f = a / (l * a + __builtin_amdgcn_exp2f(sink - M));
    bf16_t* yp = Y + (rowbase + qpos0 + w * 16 + l15) * D + 640 + hq * 64 + g * 4;
#pragma unroll
    for (int et = 0; et < 4; ++et) {
      uint2 ov; ov.x = pack2(o[hd][et][0] * f, o[hd][et][1] * f); ov.y = pack2(o[hd][et][2] * f, o[hd][et][3] * f);
      *(uint2*)(yp + et * 16) = ov;
    }
  }
}

DI void na4_item(const Params& p, int layer, int b, int h, int qt4, char* smem) {
  char* sK = smem;
  char* sV = smem + 32768;
  float* sBias = (float*)(smem + 65536);
  const bf16_t* P = (const bf16_t*)(p.ws + OFF_P);
  const bf16_t* VT = (const bf16_t*)(p.ws + OFF_VT);
  bf16_t* Y = (bf16_t*)(p.ws + OFF_H);
  const int tid = otid(), lane = tid & 63, w = tid >> 6, l15 = lane & 15, g = lane >> 4;
  const int qcol = 768 + h * 64, kcol = 1152 + h * 64, hv = 4 + h, ycol = 256 + h * 64;
  const size_t rowbase = (size_t)b * S;
  const int r0 = 4 * qt4, c0 = 16 * (w & 3);
  int rq[2], rsq[2];
#pragma unroll
  for (int q = 0; q < 2; ++q) { rq[q] = r0 + (w >> 2) + 2 * q; int t_ = rq[q] - 4; rsq[q] = t_ < 0 ? 0 : (t_ > 56 ? 56 : t_); }
  int rs0 = r0 - 4, rsL = r0 - 1;
  rs0 = rs0 < 0 ? 0 : (rs0 > 56 ? 56 : rs0); rsL = rsL < 0 ? 0 : (rsL > 56 ? 56 : rsL);
  const int npair = (rsL - rs0 + 9) >> 1, ntiles = 4 + npair;
  int kc0 = c0 - 8; kc0 = kc0 < 0 ? 0 : (kc0 > 32 ? 32 : kc0);
  const int lr = tid >> 3, c8 = tid & 7;
  const bf16_t* kbase = P + (rowbase + lr) * PW + kcol + c8 * 8;
  const bf16_t* vbase = VT + ((size_t)(b * 12 + hv) * 64 + lr) * S + c8 * 8;
  const int wofs = lds_byte(lr, c8 * 8);
  const int kl = 8 * (l15 >> 2) + (l15 & 3);
  const int kofs0 = lds_byte(kl, g * 8), kofs1 = lds_byte(kl + 4, g * 8);
  const int lk0 = lds_byte(kc0 + kl, g * 8), lk1 = lds_byte(kc0 + kl + 4, g * 8);
  const int vofs = lds_byte(l15, g * 8);
  const int lvofs = lds_byte(l15, kc0 + g * 8);
  auto pos_of = [&](int it, int r) -> int { if (it < 4) return 64 * it; int kr_ = rs0 + 2 * (it - 4) + r; kr_ = kr_ > 63 ? 63 : kr_; return L + kr_ * 64; };
  u32x4 kr0 = *(const u32x4*)(kbase), vr0 = *(const u32x4*)(vbase), kr1, vr1;
  kr1 = kr0; vr1 = vr0;
  __syncthreads();
  if (tid < 480) { int dr = tid >> 5, dc = tid & 31; sBias[tid] = dc < 31 ? p.na_rpb[(size_t)(layer * 6 + h) * 465 + dr * 31 + dc] * LOG2E : -INFINITY; }
  *(u32x4*)(sK + wofs) = kr0; *(u32x4*)(sV + wofs) = vr0;
  kr0 = *(const u32x4*)(kbase + (size_t)64 * PW); vr0 = *(const u32x4*)(vbase + 64);
  bf16x8 aq[2][2];
  f32x4 o[2][4];
  float m[2], ls[2];
  float minit = -1e30f; asm volatile("" : "+v"(minit));
#pragma unroll
  for (int q = 0; q < 2; ++q) {
    const bf16_t* qp = P + (rowbase + L + rq[q] * 64 + c0 + l15) * PW + qcol + g * 8;
    aq[q][0] = *(const bf16x8*)qp; aq[q][1] = *(const bf16x8*)(qp + 32);
    m[q] = minit; ls[q] = 0.f;
#pragma unroll
    for (int i = 0; i < 4; ++i) o[q][i] = (f32x4){0.f, 0.f, 0.f, 0.f};
  }
  int boff[8];
  {
    const int qi = c0 + l15;
    int wsr = qi - 8; wsr = wsr < 0 ? 0 : (wsr > 48 ? 48 : wsr);
#pragma unroll
    for (int hh = 0; hh < 2; ++hh)
#pragma unroll
      for (int j = 0; j < 4; ++j) {
        int kk = kc0 + 8 * g + 4 * hh + j;
        boff[hh * 4 + j] = ((kk >= wsr) && (kk < wsr + 16)) ? kk - qi + 15 : 31;
      }
  }
  __syncthreads();
  for (int it = 0; it < ntiles; ++it) {
    const int cur = it & 1;
    if (it + 1 < ntiles) {
      char* dk = sK + (cur ^ 1) * 16384 + wofs; char* dv = sV + (cur ^ 1) * 16384 + wofs;
      *(u32x4*)dk = kr0; *(u32x4*)dv = vr0;
      if (it + 1 >= 4) { *(u32x4*)(dk + 8192) = kr1; *(u32x4*)(dv + 8192) = vr1; }
      if (it + 2 < ntiles) {
        const int pa = pos_of(it + 2, 0);
        kr0 = *(const u32x4*)(kbase + (size_t)pa * PW); vr0 = *(const u32x4*)(vbase + pa);
        if (it + 2 >= 4) { const int pb_ = pos_of(it + 2, 1); kr1 = *(const u32x4*)(kbase + (size_t)pb_ * PW); vr1 = *(const u32x4*)(vbase + pb_); }
      }
    }
    const char* kb = sK + cur * 16384;
    const char* vb = sV + cur * 16384;
    const bool loc = it >= 4;
    const int krA = rs0 + 2 * (it - 4);
    bool act[2][2];
#pragma unroll
    for (int q = 0; q < 2; ++q)
#pragma unroll
      for (int ks = 0; ks < 2; ++ks) act[q][ks] = !loc || ((krA + ks >= rsq[q]) && (krA + ks < rsq[q] + 8));
    f32x4 s[2][4];
#pragma unroll
    for (int ks = 0; ks < 2; ++ks) {
      if (act[0][ks] || act[1][ks]) {
        const char* k0p = loc ? kb + ks * 8192 + lk0 : kb + kofs0 + ks * 4096;
        const char* k1p = loc ? kb + ks * 8192 + lk1 : kb + kofs1 + ks * 4096;
        const bf16x8 k00 = *(const bf16x8*)k0p, k01 = *(const bf16x8*)(k0p + 1024);
        const bf16x8 k10 = *(const bf16x8*)k1p, k11 = *(const bf16x8*)(k1p + 1024);
#pragma unroll
        for (int q = 0; q < 2; ++q) {
          if (act[q][ks]) {
            s[q][2 * ks] = MFMA16(k00, aq[q][0], ((f32x4){0.f, 0.f, 0.f, 0.f}));
            s[q][2 * ks] = MFMA16(k01, aq[q][1], s[q][2 * ks]);
            s[q][2 * ks + 1] = MFMA16(k10, aq[q][0], ((f32x4){0.f, 0.f, 0.f, 0.f}));
            s[q][2 * ks + 1] = MFMA16(k11, aq[q][1], s[q][2 * ks + 1]);
            if (loc) {
              const float* brow = sBias + (krA + ks - rq[q] + 7) * 32;
#pragma unroll
              for (int hh = 0; hh < 2; ++hh)
#pragma unroll
                for (int j = 0; j < 4; ++j) s[q][2 * ks + hh][j] += brow[boff[hh * 4 + j]];
            }
          }
        }
      }
#pragma unroll
      for (int q = 0; q < 2; ++q)
        if (!act[q][ks]) { s[q][2 * ks] = (f32x4){-INFINITY, -INFINITY, -INFINITY, -INFINITY}; s[q][2 * ks + 1] = s[q][2 * ks]; }
    }
    bf16x8 pb[2][2];
#pragma unroll
    for (int q = 0; q < 2; ++q) {
      if (act[q][0] || act[q][1]) {
        float mx = fmaxf(fmaxf(fmaxf(s[q][0][0], s[q][0][1]), fmaxf(s[q][0][2], s[q][0][3])), fmaxf(fmaxf(s[q][1][0], s[q][1][1]), fmaxf(s[q][1][2], s[q][1][3])));
        mx = fmaxf(mx, fmaxf(fmaxf(fmaxf(s[q][2][0], s[q][2][1]), fmaxf(s[q][2][2], s[q][2][3])), fmaxf(fmaxf(s[q][3][0], s[q][3][1]), fmaxf(s[q][3][2], s[q][3][3]))));
        mx = fmaxf(mx, xor_lane(mx, lane, 16));
        mx = fmaxf(mx, xor_lane(mx, lane, 32));
        if (__builtin_amdgcn_ballot_w64(mx > m[q] + 8.f) != 0ull) {
          const float mn = fmaxf(m[q], mx);
          const float alpha = __builtin_amdgcn_exp2f(m[q] - mn);
          m[q] = mn;
          ls[q] *= alpha;
#pragma unroll
          for (int et = 0; et < 4; ++et) { o[q][et][0] *= alpha; o[q][et][1] *= alpha; o[q][et][2] *= alpha; o[q][et][3] *= alpha; }
        }
        float psum = 0.f;
#pragma unroll
        for (int nt = 0; nt < 4; ++nt)
#pragma unroll
          for (int j = 0; j < 4; ++j) { float pv = __builtin_amdgcn_exp2f(s[q][nt][j] - m[q]); s[q][nt][j] = pv; psum += pv; }
        ls[q] += psum;
      }
#pragma unroll
      for (int ks = 0; ks < 2; ++ks) {
        u32x4 pk; pk.x = pack2(s[q][2 * ks][0], s[q][2 * ks][1]); pk.y = pack2(s[q][2 * ks][2], s[q][2 * ks][3]);
        pk.z = pack2(s[q][2 * ks + 1][0], s[q][2 * ks + 1][1]); pk.w = pack2(s[q][2 * ks + 1][2], s[q][2 * ks + 1][3]);
        pb[q][ks] = __builtin_bit_cast(bf16x8, pk);
      }
    }
#pragma unroll
    for (int ks = 0; ks < 2; ++ks) {
      if (act[0][ks] || act[1][ks]) {
        const char* vp = loc ? vb + ks * 8192 + lvofs : vb + vofs + ks * 1024;
#pragma unroll
        for (int et = 0; et < 4; ++et) {
          const bf16x8 vf = *(const bf16x8*)(vp + et * 2048);
#pragma unroll
          for (int q = 0; q < 2; ++q) if (act[q][ks]) o[q][et] = MFMA16(vf, pb[q][ks], o[q][et]);
        }
      }
    }
    __syncthreads();
  }
#pragma unroll
  for (int q = 0; q < 2; ++q) {
    float l = ls[q];
    l += xor_lane(l, lane, 16);
    l += xor_lane(l, lane, 32);
    const float f = 1.f / l;
    bf16_t* yp = Y + (rowbase + L + rq[q] * 64 + c0 + l15) * D + ycol + g * 4;
#pragma unroll
    for (int et = 0; et < 4; ++et) {
      uint2 ov; ov.x = pack2(o[q][et][0] * f, o[q][et][1] * f); ov.y = pack2(o[q][et][2] * f, o[q][et][3] * f);
      *(uint2*)(yp + et * 16) = ov;
    }
  }
}

struct GlaPre { float4 za; u32x4 v; float w2r[16]; float b2; };
DI void gla_preload(const Params& p, int layer, int b, int h, int c, int dir, int d, GlaPre& g) {
  const int tid = otid();
  const float* ZA = (const float*)(p.ws + OFF_ZA);
  const bf16_t* VT = (const bf16_t*)(p.ws + OFF_VT);
  const size_t row0 = (size_t)b * S + c * 64;
  g.za = *(const float4*)(ZA + row0 * 32 + tid * 4);
  const int lr = tid >> 3, lc = (tid & 7) * 8;
  g.v = *(const u32x4*)(VT + ((size_t)(b * 12 + h) * 64 + lr) * S + c * 64 + lc);
  const float* w2 = (dir == 0 ? p.wa2_f : p.wa2_b) + (size_t)layer * 16 * 256 + h * 64 + d;
#pragma unroll
  for (int r = 0; r < 16; ++r) g.w2r[r] = w2[r * 256];
  g.b2 = (dir == 0 ? p.ba_f : p.ba_b)[layer * 256 + h * 64 + d];
}
DI void gla_stage(const GlaPre& g, float* sZA, bf16_t* sV) {
  const int tid = otid();
  *(float4*)(sZA + tid * 4) = g.za;
  const int lr = tid >> 3, lc = (tid & 7) * 8;
  *(u32x4*)(sV + lr * 72 + lc) = g.v;
}
DI void gla_cum(const GlaPre& gp, int dir, int d, int qtr, const float* sZA, float* sQS  , float (&bc)[16], float& btot) {
  float la[16];
#pragma unroll
  for (int i = 0; i < 16; ++i) {
    const float* zr = sZA + (qtr * 16 + i) * 32 + dir * 16;
    float z = gp.b2;
#pragma unroll
    for (int r = 0; r < 16; ++r) z += zr[r] * gp.w2r[r];
    la[i] = log_sigmoid_f(z) * (1.f / 16.f);
  }
  float run = 0.f;
  if (dir == 0) {
#pragma unroll
    for (int i = 0; i < 16; ++i) { run += la[i]; bc[i] = run; }
  } else {
#pragma unroll
    for (int i = 15; i >= 0; --i) { run += la[i]; bc[i] = run; }
  }
  float* qs = sQS + dir * 256;
  qs[qtr * 64 + d] = run;
  __syncthreads();
  float q0 = qs[d], q1 = qs[64 + d], q2 = qs[128 + d], q3 = qs[192 + d];
  btot = q0 + q1 + q2 + q3;
  float off;
  if (dir == 0) off = (qtr > 0 ? q0 : 0.f) + (qtr > 1 ? q1 : 0.f) + (qtr > 2 ? q2 : 0.f);
  else off = (qtr < 3 ? q3 : 0.f) + (qtr < 2 ? q2 : 0.f) + (qtr < 1 ? q1 : 0.f);
#pragma unroll
  for (int i = 0; i < 16; ++i) bc[i] += off;
}

DI void gla_state_item(const Params& p, int layer, int b, int h, int c, char* smem) {
  bf16_t* sKe = (bf16_t*)smem;
  bf16_t* sV = sKe + 2 * 64 * 72;
  float* sZA = (float*)(sV + 64 * 72);
  float* sQS = sZA + 64 * 32;
  const bf16_t* P = (const bf16_t*)(p.ws + OFF_P);
  const int tid = otid(), lane = tid & 63, l15 = lane & 15, g = lane >> 4;
  const int dir = tid >> 8, wl = (tid >> 6) & 3;
  const int item = ((b * 4 + h) * 2 + dir) * NCH + c;
  bf16_t* sKd = sKe + dir * 64 * 72;
  const size_t row0 = (size_t)b * S + c * 64;
  const f32x4 zav = *(const f32x4*)((const float*)(p.ws + OFF_ZA) + row0 * 32 + tid * 4);
  const int lr = tid >> 3, lc = (tid & 7) * 8;
  const u32x4 vtile = *(const u32x4*)((const bf16_t*)(p.ws + OFF_VT) + ((size_t)(b * 12 + h) * 64 + lr) * S + c * 64 + lc);
  const float* w2 = (dir == 0 ? p.wa2_f : p.wa2_b) + (size_t)layer * 16 * 256 + h * 64 + l15;
  float w2v[4][4], b2v[4];
#pragma unroll
  for (int nt = 0; nt < 4; ++nt) {
#pragma unroll
    for (int kk = 0; kk < 4; ++kk) w2v[nt][kk] = w2[(4 * kk + g) * 256 + nt * 16];
    b2v[nt] = (dir == 0 ? p.ba_f : p.ba_b)[layer * 256 + h * 64 + nt * 16 + l15];
  }
  const bf16_t* kp = P + (row0 + wl * 16 + g * 4) * PW + 256 + h * 64 + l15;
  bf16_t kraw[4][4];
#pragma unroll
  for (int nt = 0; nt < 4; ++nt)
#pragma unroll
    for (int j = 0; j < 4; ++j) kraw[nt][j] = kp[(size_t)j * PW + nt * 16];
  __syncthreads();
  *(f32x4*)(sZA + tid * 4) = zav;
  *(u32x4*)(sV + lr * 72 + lc) = vtile;
  __syncthreads();
  float av[4];
#pragma unroll
  for (int kk = 0; kk < 4; ++kk) av[kk] = sZA[(wl * 16 + l15) * 32 + dir * 16 + 4 * kk + g];
  float bcv[4][4], tot[4];
#pragma unroll
  for (int nt = 0; nt < 4; ++nt) {
    f32x4 z = (f32x4){b2v[nt], b2v[nt], b2v[nt], b2v[nt]};
#pragma unroll
    for (int kk = 0; kk < 4; ++kk) z = __builtin_amdgcn_mfma_f32_16x16x4f32(av[kk], w2v[nt][kk], z, 0, 0, 0);
    float la[4];
#pragma unroll
    for (int j = 0; j < 4; ++j) la[j] = log_sigmoid_f(z[j]) * (1.f / 16.f);
    float run = 0.f;
    if (dir == 0) {
#pragma unroll
      for (int j = 0; j < 4; ++j) { run += la[j]; bcv[nt][j] = run; }
    } else {
#pragma unroll
      for (int j = 3; j >= 0; --j) { run += la[j]; bcv[nt][j] = run; }
    }
    const float p1 = xor_lane(run, lane, 16);
    const float pr = run + p1;
    const float p2 = xor_lane(pr, lane, 32);
    float off;
    if (dir == 0) off = ((g & 1) ? p1 : 0.f) + ((g & 2) ? p2 : 0.f);
    else off = ((g & 1) ? 0.f : p1) + ((g & 2) ? 0.f : p2);
#pragma unroll
    for (int j = 0; j < 4; ++j) bcv[nt][j] += off;
    tot[nt] = pr + p2;
  }
  float* qs = sQS + dir * 256;
  if (g == 0) {
#pragma unroll
    for (int nt = 0; nt < 4; ++nt) qs[wl * 64 + nt * 16 + l15] = tot[nt];
  }
  __syncthreads();
  unsigned short* BC = (unsigned short*)(p.ws + OFF_BC) + (size_t)item * 4096 + (wl * 16 + g * 4) * 64 + l15;
#pragma unroll
  for (int nt = 0; nt < 4; ++nt) {
    const int d = nt * 16 + l15;
    const float q0 = qs[d], q1 = qs[64 + d], q2 = qs[128 + d], q3 = qs[192 + d];
    const float btot = q0 + q1 + q2 + q3;
    float off;
    if (dir == 0) off = (wl > 0 ? q0 : 0.f) + (wl > 1 ? q1 : 0.f) + (wl > 2 ? q2 : 0.f);
    else off = (wl < 3 ? q3 : 0.f) + (wl < 2 ? q2 : 0.f) + (wl < 1 ? q1 : 0.f);
    float ke[4];
#pragma unroll
    for (int j = 0; j < 4; ++j) {
      const float bc = bcv[nt][j] + off;
      float q = fminf(-bc * 2048.f + 0.5f, 65535.f);
      BC[j * 64 + nt * 16] = (unsigned short)(int)q;
      ke[j] = bf2f(kraw[nt][j]) * __expf(btot - bc);
    }
    uint2 o; o.x = pack2(ke[0], ke[1]); o.y = pack2(ke[2], ke[3]);
    *(uint2*)(sKd + d * 72 + wl * 16 + g * 4) = o;
    if (wl == 0 && g == 0) ((float*)(p.ws + OFF_DEC))[(size_t)item * 64 + d] = __expf(btot);
  }
  __syncthreads();
  const bf16x8 a0 = *(const bf16x8*)(sKd + (wl * 16 + l15) * 72 + g * 8), a1 = *(const bf16x8*)(sKd + (wl * 16 + l15) * 72 + 32 + g * 8);
  float* CST = (float*)(p.ws + OFF_CST) + (size_t)item * 4096;
#pragma unroll
  for (int nt = 0; nt < 4; ++nt) {
    const bf16_t* vp = sV + (nt * 16 + l15) * 72 + g * 8;
    bf16x8 b0 = *(const bf16x8*)vp, b1 = *(const bf16x8*)(vp + 32);
    f32x4 acc = MFMA16(a0, b0, ((f32x4){0.f, 0.f, 0.f, 0.f}));
    acc = MFMA16(a1, b1, acc);
    *(f32x4*)(CST + (nt * 16 + l15) * 64 + wl * 16 + g * 4) = acc;
  }
}

DI void gla_scan_item(const Params& p, int item) {
  const int seq = item >> 3, idx = (item & 7) * NTHR + otid(), dir = seq & 1, d = idx & 63;
  float* CST = (float*)(p.ws + OFF_CST) + (size_t)seq * NCH * 4096 + idx;
  const float* DEC = (const float*)(p.ws + OFF_DEC) + (size_t)seq * NCH * 64 + d;
  float state = 0.f;
  for (int s0 = 0; s0 < NCH; s0 += 17) {
    float tv[17], dv[17]; int cc[17];
#pragma unroll
    for (int u = 0; u < 17; ++u) {
      int step = s0 + u;
      cc[u] = dir == 0 ? step : (step < 4 ? 3 - step : 71 - step);
      tv[u] = CST[(size_t)cc[u] * 4096];
      dv[u] = DEC[cc[u] * 64];
    }
#pragma unroll
    for (int u = 0; u < 17; ++u) {
      CST[(size_t)cc[u] * 4096] = state;
      state = dv[u] * state + tv[u];
    }
  }
}

DI void gla_out_item(const Params& p, int layer, int b, int h, int c, char* smem) {
  bf16_t* sQ = (bf16_t*)smem;
  bf16_t* sK = sQ + 2 * 64 * 72;
  bf16_t* sS = sK + 2 * 64 * 72;
  bf16_t* sV = sS + 2 * 64 * 72;
  bf16_t* sP = sV + 64 * 72;
  float* sZA = (float*)(sP + 8 * 16 * 72);
  float* sQS = sZA + 64 * 32;
  float* sO = sQS + 512;
  const bf16_t* P = (const bf16_t*)(p.ws + OFF_P);
  bf16_t* Y = (bf16_t*)(p.ws + OFF_H);
  const int tid = otid(), lane = tid & 63, w = tid >> 6, l15 = lane & 15, g = lane >> 4;
  const int dir = tid >> 8, d = tid & 63, qtr = (tid >> 6) & 3, wl = w & 3;
  const size_t row0 = (size_t)b * S + c * 64;
  bf16_t* sQd = sQ + dir * 64 * 72; bf16_t* sKd = sK + dir * 64 * 72; bf16_t* sSd = sS + dir * 64 * 72;
  const int lr_ = tid >> 3, lc_ = (tid & 7) * 8;
  const u32x4 vtile = *(const u32x4*)((const bf16_t*)(p.ws + OFF_VT) + ((size_t)(b * 12 + h) * 64 + lr_) * S + c * 64 + lc_);
  const unsigned short* BC = (const unsigned short*)(p.ws + OFF_BC) + (size_t)(((b * 4 + h) * 2 + dir) * NCH + c) * 4096 + (qtr * 16) * 64 + d;
  unsigned short bcq[16];
#pragma unroll
  for (int i = 0; i < 16; ++i) bcq[i] = BC[i * 64];
  const bf16_t* qp = P + (row0 + qtr * 16) * PW + h * 64 + d;
  bf16_t qraw[16], kraw[16];
#pragma unroll
  for (int i = 0; i < 16; ++i) { qraw[i] = qp[(size_t)i * PW]; kraw[i] = qp[(size_t)i * PW + 256]; }
  const float* SE = (const float*)(p.ws + OFF_CST) + (size_t)(((b * 4 + h) * 2 + dir) * NCH + c) * 4096;
  const int t8 = tid & 255;
  float4 sev[4];
#pragma unroll
  for (int i = 0; i < 4; ++i) { int idx = i * 256 + t8; sev[i] = *(const float4*)(SE + (idx >> 4) * 64 + (idx & 15) * 4); }
  __syncthreads();
  *(u32x4*)(sV + lr_ * 72 + lc_) = vtile;
#pragma unroll
  for (int i = 0; i < 4; ++i) {
    int idx = i * 256 + t8, e = idx >> 4, d4 = (idx & 15) * 4;
    uint2 pk; pk.x = pack2(sev[i].x, sev[i].y); pk.y = pack2(sev[i].z, sev[i].w);
    *(uint2*)(sSd + e * 72 + d4) = pk;
  }
  f32x4 o[4];
#pragma unroll
  for (int i = 0; i < 4; ++i) o[i] = (f32x4){0.f, 0.f, 0.f, 0.f};
  bf16_t* sPw = sP + w * 16 * 72;
  {
    float bc[16];
#pragma unroll
    for (int i = 0; i < 16; ++i) bc[i] = (float)bcq[i] * (-1.f / 2048.f);
#pragma unroll
    for (int i = 0; i < 16; ++i) {
      sQd[(qtr * 16 + i) * 72 + d] = f2bf(bf2f(qraw[i]) * __expf(bc[i]));
      sKd[(qtr * 16 + i) * 72 + d] = f2bf(bf2f(kraw[i]) * __expf(-bc[i]));
    }
    __syncthreads();
    const bf16x8 aq0 = *(const bf16x8*)(sQd + (wl * 16 + l15) * 72 + g * 8), aq1 = *(const bf16x8*)(sQd + (wl * 16 + l15) * 72 + 32 + g * 8);
#pragma unroll
    for (int nt = 0; nt < 4; ++nt) {
      const bf16_t* kp = sKd + (nt * 16 + l15) * 72 + g * 8;
      bf16x8 b0 = *(const bf16x8*)kp, b1 = *(const bf16x8*)(kp + 32);
      f32x4 s = MFMA16(aq0, b0, ((f32x4){0.f, 0.f, 0.f, 0.f}));
      s = MFMA16(aq1, b1, s);
#pragma unroll
      for (int j = 0; j < 4; ++j) {
        int qi = wl * 16 + g * 4 + j, ki = nt * 16 + l15;
        bool keep = dir == 0 ? (ki <= qi) : (ki >= qi);
        sPw[(g * 4 + j) * 72 + nt * 16 + l15] = f2bf(keep ? s[j] : 0.f);
      }
      const bf16_t* sp = sSd + (nt * 16 + l15) * 72 + g * 8;
      bf16x8 c0 = *(const bf16x8*)sp, c1 = *(const bf16x8*)(sp + 32);
      o[nt] = MFMA16(aq0, c0, o[nt]);
      o[nt] = MFMA16(aq1, c1, o[nt]);
    }
    __syncthreads();
    const bf16x8 ap0 = *(const bf16x8*)(sPw + l15 * 72 + g * 8), ap1 = *(const bf16x8*)(sPw + l15 * 72 + 32 + g * 8);
#pragma unroll
    for (int nt = 0; nt < 4; ++nt) {
      const bf16_t* vp = sV + (nt * 16 + l15) * 72 + g * 8;
      bf16x8 b0 = *(const bf16x8*)vp, b1 = *(const bf16x8*)(vp + 32);
      o[nt] = MFMA16(ap0, b0, o[nt]);
      o[nt] = MFMA16(ap1, b1, o[nt]);
    }
  }
  if (dir == 1) {
#pragma unroll
    for (int nt = 0; nt < 4; ++nt)
#pragma unroll
      for (int j = 0; j < 4; ++j) sO[(wl * 16 + g * 4 + j) * 65 + nt * 16 + l15] = o[nt][j];
  }
  __syncthreads();
  if (dir == 0) {
    const float* gn = p.gla_norm + layer * 256 + h * 64;
#pragma unroll
    for (int j = 0; j < 4; ++j) {
      float ov[4];
#pragma unroll
      for (int nt = 0; nt < 4; ++nt) ov[nt] = o[nt][j] + sO[(wl * 16 + g * 4 + j) * 65 + nt * 16 + l15];
      float ss = ov[0] * ov[0] + ov[1] * ov[1] + ov[2] * ov[2] + ov[3] * ov[3];
      ss = sum16(ss);
      const float rstd = rsqrtf(ss * (1.f / 64.f) + EPS);
      const size_t row = row0 + wl * 16 + g * 4 + j;
#pragma unroll
      for (int nt = 0; nt < 4; ++nt) {
        int e = nt * 16 + l15;
        float gv = bf2f(P[row * PW + 512 + h * 64 + e]);
        Y[row * D + h * 64 + e] = f2bf(ov[nt] * rstd * gn[e] * silu_f(gv));
      }
    }
  }
}

#define XB_TMO      128
#define XB_XCNT(j)  (256  + 64 * (j))
#define XB_XSUB(j)  (1280 + 64 * (j))
#define XB_XGEN(j)  (2304 + 64 * (j))
#define XB_TOP      3328
#define XB_TOPGEN   3392
#define XCD_BAR_WORDS 3456
#define XB_SPIN_CAP (1u << 22)
#define LAS __attribute__((address_space(3)))
DI unsigned xb_ld(unsigned* p) { return __hip_atomic_load(p, __ATOMIC_RELAXED, __HIP_MEMORY_SCOPE_AGENT); }
DI unsigned xb_add(unsigned* p, unsigned v) { return __hip_atomic_fetch_add(p, v, __ATOMIC_RELAXED, __HIP_MEMORY_SCOPE_AGENT); }
DI unsigned xb_xcc_id() { return (unsigned)__builtin_amdgcn_s_getreg((3 << 11) | 20) & 0xFu; }
#define XB_SPIN(cond, bar) do { unsigned _sp = 0; while (cond) { __builtin_amdgcn_s_sleep(1); \
    if ((++_sp & 255u) == 0u) { if (xb_ld(&(bar)[XB_TMO])) break; if (_sp > XB_SPIN_CAP) { atomicAdd(&(bar)[XB_TMO], 1u); break; } } } } while (0)
struct XcdBarrier { unsigned* bar; unsigned x; volatile LAS unsigned* st; };
DI XcdBarrier xcd_barrier_post(unsigned* bar, volatile LAS unsigned* st) {
  XcdBarrier b; b.bar = bar; b.x = 0u; b.st = st;
  if (threadIdx.x == 0) { const unsigned x = xb_xcc_id(); st[2] = x; (void)xb_add(&bar[XB_XCNT(x)], 1u); }
  return b;
}
DI void xcd_barrier_complete(unsigned* bar, unsigned x, unsigned& nloc, unsigned& nx) {
  const unsigned G = gridDim.x * gridDim.y * gridDim.z;
  unsigned sum, cnt, mine, sp = 0u;
  for (;;) {
    sum = 0u; cnt = 0u; mine = 0u;
#pragma unroll
    for (unsigned j = 0; j < 16; ++j) { const unsigned c = xb_ld(&bar[XB_XCNT(j)]); sum += c; cnt += (c > 0u) ? 1u : 0u; mine = (j == x) ? c : mine; }
    if (sum == G) break;
    __builtin_amdgcn_s_sleep(1);
    if ((++sp & 255u) == 0u) { if (xb_ld(&bar[XB_TMO])) break; if (sp > XB_SPIN_CAP) { atomicAdd(&bar[XB_TMO], 1u); break; } }
  }
  nloc = mine > 0u ? mine : 1u; nx = cnt > 0u ? cnt : 1u;
}
DI void xcd_barrier(const XcdBarrier& b) {
  asm volatile("s_waitcnt vmcnt(0)" ::: "memory");
  __syncthreads();
  if (threadIdx.x == 0) {
    unsigned* bar = b.bar;
    __builtin_amdgcn_s_waitcnt(0);
    unsigned nloc = b.st[0], nx = b.st[1];
    const unsigned bx = b.st[2];
    if (nloc == 0u) { xcd_barrier_complete(bar, bx, nloc, nx); b.st[0] = nloc; b.st[1] = nx; }
    const unsigned old = xb_add(&bar[XB_XSUB(bx)], 1u);
    const unsigned gen = old / nloc;
    if (old + 1u == (gen + 1u) * nloc) {
      __builtin_amdgcn_fence(__ATOMIC_RELEASE, "agent");
      asm volatile("s_waitcnt vmcnt(0)" ::: "memory");
      const unsigned og = xb_add(&bar[XB_TOP], 1u);
      const unsigned tg = og / nx;
      if (og + 1u == (tg + 1u) * nx) xb_add(&bar[XB_TOPGEN], 1u);
      else XB_SPIN(xb_ld(&bar[XB_TOPGEN]) == tg, bar);
      __builtin_amdgcn_fence(__ATOMIC_ACQUIRE, "agent");
      xb_add(&bar[XB_XGEN(bx)], 1u);
      asm volatile("s_waitcnt vmcnt(0)" ::: "memory");
    } else {
      XB_SPIN(xb_ld(&bar[XB_XGEN(bx)]) == gen, bar);
      __builtin_amdgcn_fence(__ATOMIC_ACQUIRE, "agent");
      asm volatile("s_waitcnt vmcnt(0)" ::: "memory");
    }
  }
  __syncthreads();
}

constexpr int C_IN = 45 * 8, C_OUT = 16 * 8, C_GU = 88 * 8, C_D = 16 * 22;
constexpr int N_CONV_L = C_IN + C_OUT + C_GU + C_D;
DI void conv_dispatch(const Params& p, int layer, int ci, char* smem) {
  if (ci < C_IN) conv_item(p, 0, layer, ci >> 3, ci & 7, smem);
  else if (ci < C_IN + C_OUT) { ci -= C_IN; conv_item(p, 1, layer, ci >> 3, ci & 7, smem); }
  else if (ci < C_IN + C_OUT + C_GU) { ci -= C_IN + C_OUT; conv_item(p, 2, layer, ci >> 3, ci & 7, smem); }
  else { ci -= C_IN + C_OUT + C_GU; conv_item(p, 3, layer, ci / 22, ci % 22, smem); }
}

DI void tail_conv(const Params& p, int layer, int lo, int hi, int nfull, char* smem) {
  const int bid = blockIdx.x, nb = gridDim.x;
  if (bid >= nfull) for (int ci = lo + bid - nfull; ci < hi; ci += nb - nfull) conv_dispatch(p, layer, ci, smem);
}

#define GRID_SYNC() xcd_barrier(xb)

__global__ void __launch_bounds__(512, 2) fwd_megakernel(Params p) {
  cg::grid_group grid = cg::this_grid();
  extern __shared__ __attribute__((aligned(16))) char smem[];
  __shared__ uint4 xb_words;
  const int nblk = gridDim.x, bid = blockIdx.x;
  if (threadIdx.x == 0) xb_words = make_uint4(0u, 0u, 0u, 0u);
  __syncthreads();
  XcdBarrier xb = xcd_barrier_post((unsigned*)(p.ws + OFF_BAR), (volatile LAS unsigned*)&xb_words);

  {
    constexpr int N_MOD = 768, N_ROPE = 256;
    constexpr int N_TOTAL = N_MOD + N_ROPE + C_IN;
    for (int it = bid; it < N_TOTAL; it += nblk) {
      if (it < N_MOD) mod_item(p, it, smem);
      else if (it < N_MOD + N_ROPE) rope_item(p, it - N_MOD);
      else conv_dispatch(p, 0, it - N_MOD - N_ROPE, smem);
    }
  }
  if (p.ws == nullptr) grid.sync();
  GRID_SYNC();

  const bf16_t* H = (const bf16_t*)(p.ws + OFF_H);
  const bf16_t* ACT = (const bf16_t*)(p.ws + OFF_P);
#pragma unroll 1
  for (int layer = 0; layer < 2; ++layer) {
    const bool last = layer == 1;
    norm_phase(p, layer, 0);
    GRID_SYNC();
    {
      const bf16_t* W = (const bf16_t*)(p.ws + OFF_WIN) + (size_t)layer * NIN_ROWS * D;
      const int nt_n = NIN / 256, ntiles = (R / 256) * nt_n;
      for (int t = bid; t < R / 64; t += nblk) za_item(p, layer, t, smem);
      {
        bool pf = false;
        for (int t = bid; t < ntiles; t += nblk) {
          const int t2 = t + nblk < ntiles ? t + nblk : -1;
          gemm256<EPI_IN>(p, layer, t, pf, t2, smem);
          pf = t2 >= 0;
        }
      }
    }
    GRID_SYNC();
    {
      const int n = NB * 4 * NCH;
      for (int t = bid; t < n; t += nblk) {
        int c = t % NCH, r = t / NCH;
        gla_state_item(p, layer, r >> 2, r & 3, c, smem);
      }
      if (!last) tail_conv(p, 0, C_IN, C_IN + C_OUT + C_GU, n % nblk, smem);
    }
    GRID_SYNC();
    {
      const int n_scan = 256, n_swa = NB * 2 * 32, n_na4 = 256, n_na2 = 2 * (NB * 6 * 16 - 256), n_ctx = last ? 0 : NB * 6 * 2;
      const int total = n_scan + n_swa + n_na4 + n_na2 + 2 * n_ctx;
      for (int t = bid; t < total; t += nblk) {
        int u = t;
        if (u < n_scan) { gla_scan_item(p, u); continue; }
        u -= n_scan;
        if (u < n_swa) { swa3_item(p, layer, u >> 6, (u >> 5) & 1, u & 31, smem); continue; }
        u -= n_swa;
        if (u < n_na4) { na4_item(p, layer, u / 96, (u >> 4) % 6, u & 15, smem); continue; }
        u -= n_na4;
        if (u < n_na2) { const int grp = 256 + (u >> 1); na2_item(p, layer, grp / 96, (grp >> 4) % 6, 2 * (grp & 15) + (u & 1), smem); continue; }
        u -= n_na2;
        {
          int kind = 2 + u / n_ctx; u %= n_ctx;
          int qt = u & 1, h = (u >> 1) % 6, b = u / 12;
          attn_item(p, layer, kind, b, h, qt, smem);
        }
      }
    }
    GRID_SYNC();
    {
      const int cpb = last ? 64 : NCH, n = NB * 4 * cpb;
      for (int t = bid; t < n; t += nblk) {
        int c = t % cpb + (last ? 4 : 0), r = t / cpb;
        gla_out_item(p, layer, r >> 2, r & 3, c, smem);
      }
      if (!last) { tail_conv(p, 0, C_IN + C_OUT + C_GU, N_CONV_L, n % nblk, smem);
                   tail_conv(p, 1, 0, C_IN, n % nblk, smem); }
    }
    GRID_SYNC();
    {
      const bf16_t* W = (const bf16_t*)(p.ws + OFF_WOUT) + (size_t)layer * D * D;
      const int ntiles = 256 + (last ? 0 : 64);
      bool pf = false;
      for (int t = bid; t < ntiles; t += nblk) {
        const int t2 = t + nblk < ntiles ? t + nblk : -1;
        gemm256<EPI_RES1>(p, layer, t, pf, t2, smem);
        pf = t2 >= 0;
      }
      if (!last) tail_conv(p, 1, C_IN, C_IN + C_OUT + C_GU, ntiles % nblk, smem);
    }
    GRID_SYNC();
    norm_phase(p, layer, 1);
    GRID_SYNC();
    {
      const bf16_t* W = (const bf16_t*)(p.ws + OFF_WGU) + (size_t)layer * 2 * DFF * D;
      const int mt_n = last ? 64 : 68, ntiles = mt_n * 22;
      bool pf = false;
      for (int t = bid; t < ntiles; t += nblk) {
        const int t2 = t + nblk < ntiles ? t + nblk : -1;
        gemm256<EPI_GU>(p, layer, t, pf, t2, smem);
        pf = t2 >= 0;
      }
    }
    GRID_SYNC();
    {
      const bf16_t* W = (const bf16_t*)(p.ws + OFF_WD) + (size_t)layer * D * DFF;
      const int ntiles = 256 + (last ? 0 : 176);
      bool pf = false;
      for (int t = bid; t < ntiles; t += nblk) {
        const int t2 = t + nblk < ntiles ? t + nblk : -1;
        gemm256<EPI_RES2>(p, layer, t, pf, t2, smem);
        pf = t2 >= 0;
      }
      if (!last) tail_conv(p, 1, C_IN + C_OUT + C_GU, N_CONV_L, ntiles % nblk, smem);
    }
    GRID_SYNC();
  }
  norm_phase(p, 0, 2);
}

extern "C" void kernel_launch(void* const* d_in, const int* in_sizes, int n_in, void* d_out, int out_size, void* d_ws, size_t ws_size,
                              hipStream_t stream) {
  static int grid_blocks = 0;
  if (!grid_blocks) {
    int dev = 0, cus = 0, per_cu = 0;
    (void)hipGetDevice(&dev);
    (void)hipDeviceGetAttribute(&cus, hipDeviceAttributeMultiprocessorCount, dev);
    (void)hipFuncSetAttribute((const void*)fwd_megakernel, hipFuncAttributeMaxDynamicSharedMemorySize, SMEM_BYTES);
    (void)hipOccupancyMaxActiveBlocksPerMultiprocessor(&per_cu, fwd_megakernel, NTHR, SMEM_BYTES);
    (void)hipGetLastError();
    grid_blocks = cus;
    if (ws_size < WS_END) fprintf(stderr, "workspace too small: %zu < %zu\n", ws_size, (size_t)WS_END);
    if (per_cu < 1) fprintf(stderr, "occupancy query reports %d blocks per CU\n", per_cu);
  }
  Params p{};
  const float** f = (const float**)&p;
  for (int i = 0; i < 21; ++i) f[i] = (const float*)d_in[i];
  p.out = (float*)d_out;
  p.ws = (char*)d_ws;
  void* args[] = {&p};
  (void)hipMemsetAsync((char*)d_ws + OFF_BAR, 0, 16384, stream);
  (void)hipMemsetAsync((char*)d_ws + OFF_MOD, 0, (size_t)2 * 5 * 6144 * 4, stream);
  hipError_t e = hipLaunchCooperativeKernel((void*)fwd_megakernel, dim3(grid_blocks), dim3(NTHR), args, SMEM_BYTES, stream);
  if (e != hipSuccess) fprintf(stderr, "cooperative launch failed: %s (grid %d)\n", hipGetErrorString(e), grid_blocks);
}
```

```cpp
#include <hip/hip_runtime.h>
#include <hip/hip_cooperative_groups.h>
#include <stdint.h>
#include <stdio.h>
namespace cg = cooperative_groups;

typedef __attribute__((ext_vector_type(8))) short bf16x8;
typedef __attribute__((ext_vector_type(4))) float f32x4;
typedef __attribute__((ext_vector_type(4))) unsigned u32x4;
typedef unsigned short bf16_t;
#define DI __device__ __forceinline__
#define MFMA16(a, b, c) __builtin_amdgcn_mfma_f32_16x16x32_bf16((a), (b), (c), 0, 0, 0)

constexpr int NB = 4, T = 4096, L = 256, S = 4352, R = NB * S, D = 1024, DFF = 2816;
constexpr int PW = 2048;
constexpr int NIN = 2816;
constexpr int NIN_ROWS = 2880;
constexpr int NCH = 68;
constexpr float EPS = 1e-6f;
constexpr int NTHR = 512;
constexpr float LOG2E = 1.4426950408889634f;
constexpr float QSCALE = 0.125f * 1.4426950408889634f;

constexpr size_t OFF_XC   = 0;
constexpr size_t OFF_H    = OFF_XC + (size_t)NB * L * D * 4;
constexpr size_t OFF_P    = OFF_H + (size_t)R * D * 2;
constexpr size_t OFF_VT   = OFF_P + (size_t)R * PW * 2;
constexpr size_t OFF_CST  = OFF_VT + (size_t)NB * 12 * 64 * S * 2;
constexpr size_t OFF_DEC  = OFF_CST + (size_t)NB * 4 * 2 * NCH * 4096 * 4;
constexpr size_t OFF_ZA   = OFF_DEC + (size_t)NB * 4 * 2 * NCH * 64 * 4;
constexpr size_t OFF_MOD  = OFF_ZA + (size_t)R * 32 * 4;
constexpr size_t OFF_ROPE = OFF_MOD + (size_t)2 * 5 * 6144 * 4;
constexpr size_t OFF_WIN  = OFF_ROPE + (size_t)T * 32 * 8;
constexpr size_t OFF_WOUT = OFF_WIN + (size_t)2 * NIN_ROWS * D * 2;
constexpr size_t OFF_WGU  = OFF_WOUT + (size_t)2 * D * D * 2;
constexpr size_t OFF_WD   = OFF_WGU + (size_t)2 * 2 * DFF * D * 2;
constexpr size_t OFF_BAR  = OFF_WD + (size_t)2 * D * DFF * 2;
constexpr size_t OFF_SLF  = OFF_BAR + 16384;
constexpr size_t OFF_SLI  = OFF_SLF + (size_t)4 * NB * L * D * 4;
constexpr size_t WS_END   = OFF_SLI + (size_t)3 * NB * L * D * 4;
constexpr size_t OFF_BC   = OFF_SLF;
static_assert((size_t)NB * 4 * 2 * NCH * 4096 * 2 <= WS_END - OFF_SLF, "decay buffer must fit the slab region");
static_assert(WS_END <= (size_t)256 * 1024 * 1024, "workspace layout exceeds the guaranteed 256 MiB");
static_assert((size_t)8 * NB * L * D * 4 <= (size_t)NB * 4 * 2 * NCH * 4096 * 4, "down-projection slabs 0..7 must fit the GLA state buffer");

constexpr int SMEM_BYTES = 131072;

struct Params {
  const float *x, *c, *ctx, *c_ctx, *w_mod, *b_mod, *norm_mix, *norm_ffn, *w_in, *wa2_f, *ba_f, *wa2_b, *ba_b,
      *gla_norm, *na_rpb, *swa_sink, *w_out, *w_gate, *w_up, *w_down, *final_norm;
  float* out;
  char* ws;
};

DI int otid() { int t = threadIdx.x; asm volatile("" : "+v"(t)); return t; }
typedef __bf16 hwbf2 __attribute__((ext_vector_type(2)));
typedef float f32x2 __attribute__((ext_vector_type(2)));
DI unsigned pack2(float a, float b) { f32x2 v; v.x = a; v.y = b; return __builtin_bit_cast(unsigned, __builtin_convertvector(v, hwbf2)); }
DI bf16_t f2bf(float x) { return (bf16_t)(pack2(x, 0.f) & 0xffffu); }
DI float bf2f(bf16_t h) { return __uint_as_float(((unsigned)h) << 16); }
DI float silu_f(float v) { return v * __builtin_amdgcn_rcpf(1.f + __builtin_amdgcn_exp2f(-1.4426950408889634f * v)); }
#define DPPF(v, ctrl) __builtin_bit_cast(float, __builtin_amdgcn_update_dpp(0, __builtin_bit_cast(int, (v)), (ctrl), 0xF, 0xF, true))
DI float max16(float v) { v = fmaxf(v, DPPF(v, 0xB1)); v = fmaxf(v, DPPF(v, 0x4E)); v = fmaxf(v, DPPF(v, 0x141)); v = fmaxf(v, DPPF(v, 0x140)); return v; }
DI float sum16(float v) { v += DPPF(v, 0xB1); v += DPPF(v, 0x4E); v += DPPF(v, 0x141); v += DPPF(v, 0x140); return v; }
DI float xor_lane(float v, int lane, int mask) { return __builtin_bit_cast(float, __builtin_amdgcn_ds_bpermute((lane ^ mask) << 2, __builtin_bit_cast(int, v))); }
DI float log_sigmoid_f(float z) { return fminf(z, 0.f) - __logf(1.f + __expf(-fabsf(z))); }

DI float* slab_i(const Params& p, int sl) { return (float*)(p.ws + (sl < 8 ? OFF_CST + (size_t)sl * NB * L * D * 4 : OFF_SLI + (size_t)(sl - 8) * NB * L * D * 4)); }
DI float* xrow(const Params& p, int row) {
  int b = row / S, pos = row - b * S;
  return pos < L ? (float*)(p.ws + OFF_XC) + (size_t)(b * L + pos) * D : p.out + (size_t)(b * T + pos - L) * D;
}
DI const float* xrow_in(const Params& p, int row) {
  int b = row / S, pos = row - b * S;
  return pos < L ? p.ctx + (size_t)(b * L + pos) * D : p.x + (size_t)(b * T + pos - L) * D;
}

DI void mod_item(const Params& p, int item, char* smem) {
  float* sS = (float*)smem;
  float* sR = sS + 5 * 256;
  const int tid = otid();
  const int l = item / 384, rem = item - l * 384, n0 = (rem >> 2) * 64, k0 = (rem & 3) * 256;
  __syncthreads();
  for (int i = tid; i < 5 * 256; i += NTHR) {
    int v = i >> 8, k = k0 + (i & 255);
    float cv = v < 4 ? p.c[v * 1024 + k] : p.c_ctx[k];
    sS[i] = cv / (1.f + expf(-cv));
  }
  const int col = tid & 63, kq = tid >> 6;
  const float* wp = p.w_mod + ((size_t)l * 1024 + k0 + kq * 32) * 6144 + n0 + col;
  float wv[32];
#pragma unroll
  for (int k = 0; k < 32; ++k) wv[k] = wp[(size_t)k * 6144];
  __syncthreads();
  float acc[5] = {0.f, 0.f, 0.f, 0.f, 0.f};
#pragma unroll
  for (int k = 0; k < 32; ++k)
#pragma unroll
    for (int v = 0; v < 5; ++v) acc[v] += sS[v * 256 + kq * 32 + k] * wv[k];
#pragma unroll
  for (int v = 0; v < 5; ++v) sR[(kq * 5 + v) * 64 + col] = acc[v];
  __syncthreads();
  if (tid < 320) {
    int v = tid >> 6, cc = tid & 63;
    float s = (rem & 3) == 0 ? p.b_mod[l * 6144 + n0 + cc] : 0.f;
#pragma unroll
    for (int q = 0; q < 8; ++q) s += sR[(q * 5 + v) * 64 + cc];
    (void)__hip_atomic_fetch_add((float*)(p.ws + OFF_MOD) + (size_t)(l * 5 + v) * 6144 + n0 + cc, s, __ATOMIC_RELAXED, __HIP_MEMORY_SCOPE_AGENT);
  }
}

DI void rope_item(const Params& p, int item) {
  int idx = item * NTHR + otid();
  int t = idx >> 5, i = idx & 31, f = i & 15;
  float pos = (float)(i < 16 ? (t >> 6) : (t & 63));
  float inv_freq = exp2f(-(float)f * 0.83048202372184058696f);
  float ang = pos * inv_freq;
  float n = rintf(ang * 0.15915494309189533577f);
  float r = fmaf(-n, 6.28125f, ang);
  r = fmaf(-n, 0.0019353071795864769f, r);
  float2 cs; cs.x = __cosf(r); cs.y = __sinf(r);
  ((float2*)(p.ws + OFF_ROPE))[idx] = cs;
}

DI void conv_item(const Params& p, int kind, int layer, int nt, int kt, char* smem) {
  float* sT = (float*)smem;
  const int tid = otid();
  const float* src; const float* src2 = nullptr; int ldsrc; bf16_t* dst; int ldd;
  if (kind == 0) { src = p.w_in + (size_t)layer * D * 2848; ldsrc = 2848; dst = (bf16_t*)(p.ws + OFF_WIN) + (size_t)layer * NIN_ROWS * D; ldd = D; }
  else if (kind == 1) { src = p.w_out + (size_t)layer * D * D; ldsrc = D; dst = (bf16_t*)(p.ws + OFF_WOUT) + (size_t)layer * D * D; ldd = D; }
  else if (kind == 2) { src = p.w_gate + (size_t)layer * D * DFF; src2 = p.w_up + (size_t)layer * D * DFF; ldsrc = DFF; dst = (bf16_t*)(p.ws + OFF_WGU) + (size_t)layer * 2 * DFF * D; ldd = D; }
  else { src = p.w_down + (size_t)layer * DFF * D; ldsrc = D; dst = (bf16_t*)(p.ws + OFF_WD) + (size_t)layer * D * DFF; ldd = DFF; }
  const int n0 = nt * 64, k0 = kt * 128;
  __syncthreads();
  f32x4 v[4];
#pragma unroll
  for (int i = 0; i < 4; ++i) {
    int idx = i * NTHR + tid, kk = idx >> 4, np = n0 + (idx & 15) * 4;
    const float* sp = nullptr;
    if (kind == 0) {
      int sc;
      if (np < 1024) sc = np;
      else if (np < 2176) sc = np + 32;
      else if (np < 2688) { int rel = np - 2176, head = rel >> 6, wi = rel & 63; int dd = ((wi >> 5) << 4) + (wi & 15) + (((wi >> 4) & 1) << 5); sc = 2208 + head * 64 + dd; }
      else if (np < 2816) sc = np + 32;
      else if (np < 2848) sc = np - 2816 + 1024;
      else sc = -1;
      if (sc >= 0) sp = src + (size_t)(k0 + kk) * ldsrc + sc;
    } else if (kind == 2) {
      int j = np >> 5, rr = np & 31;
      sp = (rr < 16 ? src + j * 16 + rr : src2 + j * 16 + rr - 16) + (size_t)(k0 + kk) * ldsrc;
    } else {
      sp = src + (size_t)(k0 + kk) * ldsrc + np;
    }
    v[i] = sp ? *(const f32x4*)sp : (f32x4){0.f, 0.f, 0.f, 0.f};
  }
#pragma unroll
  for (int i = 0; i < 4; ++i) {
    int idx = i * NTHR + tid, kk = idx >> 4, nn = (idx & 15) * 4;
    *(f32x4*)(sT + kk * 68 + nn) = v[i];
  }
  __syncthreads();
#pragma unroll
  for (int i = 0; i < 2; ++i) {
    int idx = i * NTHR + tid, nn = idx >> 4, kc = (idx & 15) * 8;
    float e[8];
#pragma unroll
    for (int q = 0; q < 8; ++q) e[q] = sT[(kc + q) * 68 + nn];
    u32x4 o; o.x = pack2(e[0], e[1]); o.y = pack2(e[2], e[3]); o.z = pack2(e[4], e[5]); o.w = pack2(e[6], e[7]);
    *(u32x4*)(dst + (size_t)(n0 + nn) * ldd + k0 + kc) = o;
  }
}

DI void norm_phase(const Params& p, int layer, int mode) {
  const int lane = otid() & 63;
  const int gw = blockIdx.x * 8 + (otid() >> 6), nw = gridDim.x * 8;
  const float* gvec = mode == 0 ? p.norm_mix + layer * D : (mode == 1 ? p.norm_ffn + layer * D : p.final_norm);
  const float* MOD = (const float*)(p.ws + OFF_MOD);
  bf16_t* H = (bf16_t*)(p.ws + OFF_H);
  const bool skip_ctx = (mode == 2) || (mode == 1 && layer == 1);
  const int nrows = skip_ctx ? NB * T : R;
  f32x4 v[4], vn[4];
  if (gw < nrows) {
    const int row_ = skip_ctx ? (gw / T) * S + L + (gw % T) : gw;
    const float* src_ = (mode == 0 && layer == 0) ? xrow_in(p, row_) : xrow(p, row_);
#pragma unroll
    for (int i = 0; i < 4; ++i) v[i] = *(const f32x4*)(src_ + i * 256 + lane * 4);
  }
  for (int ri = gw; ri < nrows; ri += nw) {
    int row = skip_ctx ? (ri / T) * S + L + (ri % T) : ri;
    int b = row / S, pos = row - b * S;
    if (ri + nw < nrows) {
      const int rn_ = ri + nw, row_ = skip_ctx ? (rn_ / T) * S + L + (rn_ % T) : rn_;
      const float* src_ = (mode == 0 && layer == 0) ? xrow_in(p, row_) : xrow(p, row_);
#pragma unroll
      for (int i = 0; i < 4; ++i) vn[i] = *(const f32x4*)(src_ + i * 256 + lane * 4);
    }
    float ss = 0.f;
    if (pos < L && ((mode == 1 && layer == 0) || (mode == 0 && layer == 1))) {
      const size_t co = (size_t)(b * L + pos) * D;
      const int nsl = mode == 1 ? 4 : 11;
      for (int sl = 0; sl < nsl; ++sl) {
        const float* sp = (mode == 1 ? (const float*)(p.ws + OFF_SLF) + (size_t)sl * NB * L * D : slab_i(p, sl)) + co;
#pragma unroll
        for (int i = 0; i < 4; ++i) v[i] += *(const f32x4*)(sp + i * 256 + lane * 4);
      }
      if (mode == 1) {
        float* xd = xrow(p, row);
#pragma unroll
        for (int i = 0; i < 4; ++i) *(f32x4*)(xd + i * 256 + lane * 4) = v[i];
      }
    }
#pragma unroll
    for (int i = 0; i < 4; ++i) ss += v[i].x * v[i].x + v[i].y * v[i].y + v[i].z * v[i].z + v[i].w * v[i].w;
    ss = sum16(ss);
    ss += xor_lane(ss, lane, 16);
    ss += xor_lane(ss, lane, 32);
    const float rstd = rsqrtf(ss * (1.f / 1024.f) + EPS);
    if (mode == 2) {
      float* dst = p.out + (size_t)(b * T + pos - L) * D;
#pragma unroll
      for (int i = 0; i < 4; ++i) {
        float4 g = *(const float4*)(gvec + i * 256 + lane * 4);
        float4 o; o.x = v[i].x * rstd * g.x; o.y = v[i].y * rstd * g.y; o.z = v[i].z * rstd * g.z; o.w = v[i].w * rstd * g.w;
        *(float4*)(dst + i * 256 + lane * 4) = o;
      }
    } else {
      const int mv = pos < L ? 4 : b;
      const float* sh = MOD + (size_t)(layer * 5 + mv) * 6144 + (mode == 0 ? 0 : 3072);
      const float* sc = sh + 1024;
      if (mode == 0 && layer == 0) {
        float* xd = xrow(p, row);
#pragma unroll
        for (int i = 0; i < 4; ++i) *(f32x4*)(xd + i * 256 + lane * 4) = v[i];
      }
#pragma unroll
      for (int i = 0; i < 4; ++i) {
        float4 g = *(const float4*)(gvec + i * 256 + lane * 4);
        float4 s1 = *(const float4*)(sc + i * 256 + lane * 4);
        float4 s0 = *(const float4*)(sh + i * 256 + lane * 4);
        float a0 = v[i].x * rstd * g.x * (1.f + s1.x) + s0.x;
        float a1 = v[i].y * rstd * g.y * (1.f + s1.y) + s0.y;
        float a2 = v[i].z * rstd * g.z * (1.f + s1.z) + s0.z;
        float a3 = v[i].w * rstd * g.w * (1.f + s1.w) + s0.w;
        uint2 o; o.x = pack2(a0, a1); o.y = pack2(a2, a3);
        *(uint2*)(H + (size_t)row * D + i * 256 + lane * 4) = o;
      }
    }
#pragma unroll
    for (int i = 0; i < 4; ++i) v[i] = vn[i];
  }
}

enum { EPI_IN = 0, EPI_RES1 = 1, EPI_GU = 2, EPI_RES2 = 3 };
constexpr int HT_B = 128 * 64 * 2;

DI int lds_byte(int r, int c) { int st = (r >> 4) * 2 + (c >> 5), rr = r & 15, cc = c & 31, ob = rr * 64 + cc * 2; return st * 1024 + (ob ^ (((ob >> 9) & 1) << 5)); }
DI void stage_rc(int b, int& Rr, int& Cc) { int st = b >> 10, sb = b & 1023, swz = sb ^ (((sb >> 9) & 1) << 5); Rr = (st >> 1) * 16 + (swz >> 6); Cc = (st & 1) * 32 + ((swz & 63) >> 1); }

struct Tile { int K, koff, brow, bcol, atomic; };
DI int mtile_row0(int idx, bool skip_ctx) { return skip_ctx ? (idx >> 4) * S + L + (idx & 15) * 256 : idx * 256; }
template <int EPI>
DI Tile tile_of(int layer, int t) {
  if constexpr (EPI == EPI_IN) { return (Tile){D, 0, (t / 11) * 256, (t % 11) * 256, 0}; }
  else if constexpr (EPI == EPI_GU) { return (Tile){D, 0, mtile_row0(t / 22, layer == 1), (t % 22) * 256, 0}; }
  else if constexpr (EPI == EPI_RES1) {
    if (t < 256) return (Tile){D, 0, mtile_row0(t >> 2, true), (t & 3) * 256, 0};
    int v = t - 256, tile = v >> 2; return (Tile){256, (v & 3) * 256, (tile >> 2) * S, (tile & 3) * 256, 1};
  } else {
    if (t < 256) return (Tile){DFF, 0, mtile_row0(t >> 2, true), (t & 3) * 256, 0};
    int v = t - 256, tile = v / 11; return (Tile){256, (v - tile * 11) * 256, (tile >> 2) * S, (tile & 3) * 256, 1};
  }
}

template <int EPI>
DI void gemm256(const Params& p, int layer, int tcur, bool prefetched, int tnext, char* shm) {
  const Tile tc = tile_of<EPI>(layer, tcur);
  const int K = tc.K, brow = tc.brow, bcol = tc.bcol;
  const bool atomic = tc.atomic != 0;
  constexpr int lda = (EPI == EPI_RES2) ? DFF : D, ldb = lda;
  const bf16_t* A0 = (const bf16_t*)(p.ws + (EPI == EPI_RES2 ? OFF_P : OFF_H));
  const bf16_t* Bt0 = (const bf16_t*)(p.ws + (EPI == EPI_IN ? OFF_WIN + (size_t)layer * NIN_ROWS * D * 2 : EPI == EPI_RES1 ? OFF_WOUT + (size_t)layer * D * D * 2
                                              : EPI == EPI_GU ? OFF_WGU + (size_t)layer * 2 * DFF * D * 2 : OFF_WD + (size_t)layer * D * DFF * 2));
  const bf16_t* A = A0 + tc.koff; const bf16_t* Bt = Bt0 + tc.koff;
  const int tid = otid();
  const int wid = tid >> 6, lane = tid & 63, wr = wid >> 2, wc = wid & 3, fr = lane & 15, fq = lane >> 4;
#define SA(b, h) (shm + ((b) * 2 + (h)) * HT_B)
#define SB(b, h) (shm + (4 + (b) * 2 + (h)) * HT_B)
  int sr0, sc0, sr1, sc1;
  stage_rc(tid * 16, sr0, sc0);
  stage_rc(tid * 16 + 8192, sr1, sc1);
  const unsigned oa0 = (unsigned)(sr0 * lda + sc0) * 2u, oa1 = (unsigned)(sr1 * lda + sc1) * 2u;
  const unsigned ob0 = (unsigned)(sr0 * ldb + sc0) * 2u, ob1 = (unsigned)(sr1 * ldb + sc1) * 2u;
#define STAGE_A(Pp, BASE, br, kt) do { const char* _gb = (const char*)((BASE) + (long)(br) * lda + (long)(kt) * 64);                 \
    unsigned _o0 = oa0, _o1 = oa1; asm volatile("" : "+v"(_o0), "+v"(_o1));                                                          \
    __builtin_amdgcn_global_load_lds((const unsigned*)(_gb + _o0), (unsigned*)((Pp) + tid * 16), 16, 0, 0);        \
    __builtin_amdgcn_global_load_lds((const unsigned*)(_gb + _o1), (unsigned*)((Pp) + tid * 16 + 8192), 16, 0, 0); } while (0)
#define STAGE_B(Pp, BASE, br, kt) do { const char* _gb = (const char*)((BASE) + (long)(br) * ldb + (long)(kt) * 64);                 \
    unsigned _o0 = ob0, _o1 = ob1; asm volatile("" : "+v"(_o0), "+v"(_o1));                                                          \
    __builtin_amdgcn_global_load_lds((const unsigned*)(_gb + _o0), (unsigned*)((Pp) + tid * 16), 16, 0, 0);        \
    __builtin_amdgcn_global_load_lds((const unsigned*)(_gb + _o1), (unsigned*)((Pp) + tid * 16 + 8192), 16, 0, 0); } while (0)
#define LDA(dst, b, h) _Pragma("unroll") for (int m = 0; m < 4; ++m) _Pragma("unroll") for (int k = 0; k < 2; ++k) \
    dst[m][k] = *reinterpret_cast<const bf16x8*>(SA(b, h) + lds_byte(wr * 64 + m * 16 + fr, k * 32 + fq * 8))
#define LDB(dst, b, h) _Pragma("unroll") for (int n = 0; n < 2; ++n) _Pragma("unroll") for (int k = 0; k < 2; ++k) \
    dst[n][k] = *reinterpret_cast<const bf16x8*>(SB(b, h) + lds_byte(wc * 32 + n * 16 + fr, k * 32 + fq * 8))
#define MMA(ai, bj, At_, Bt_) do { __builtin_amdgcn_s_setprio(1);                                                    \
    _Pragma("unroll") for (int m = 0; m < 4; ++m) _Pragma("unroll") for (int n = 0; n < 2; ++n) _Pragma("unroll") for (int k = 0; k < 2; ++k) \
      acc[ai][bj][m][n] = MFMA16(At_[m][k], Bt_[n][k], acc[ai][bj][m][n]);                                            \
    __builtin_amdgcn_s_setprio(0); } while (0)
#define WAIT_V(n) asm volatile("s_waitcnt vmcnt(" #n ")" ::: "memory")
#define WAIT_L(n) asm volatile("s_waitcnt lgkmcnt(" #n ")" ::: "memory")
#define BAR __builtin_amdgcn_s_barrier()
#define SCHED __builtin_amdgcn_sched_barrier(0)
  f32x4 acc[2][2][4][2];
#pragma unroll
  for (int a = 0; a < 2; ++a)
#pragma unroll
    for (int b = 0; b < 2; ++b)
#pragma unroll
      for (int m = 0; m < 4; ++m)
#pragma unroll
        for (int n = 0; n < 2; ++n) acc[a][b][m][n] = (f32x4){0.f, 0.f, 0.f, 0.f};
  bf16x8 At[4][2], B0[2][2], B1[2][2];
  const int nt = K / 64;
  if (!prefetched) {
    __syncthreads();
    STAGE_B(SB(0, 0), Bt, bcol, 0); STAGE_A(SA(0, 0), A, brow, 0);
    STAGE_B(SB(0, 1), Bt, bcol + 128, 0); STAGE_A(SA(0, 1), A, brow + 128, 0);
    if (wr == 1) BAR;
    WAIT_V(4); BAR;
    STAGE_B(SB(1, 0), Bt, bcol, 1); STAGE_A(SA(1, 0), A, brow, 1); STAGE_B(SB(1, 1), Bt, bcol + 128, 1);
    WAIT_V(6); BAR;
  } else {
    if (wr == 1) BAR;
    WAIT_V(0); BAR;
    BAR;
  }
  for (int t = 0; t < nt - 2; t += 2) {
    LDB(B0, 0, 0); SCHED; LDA(At, 0, 0); STAGE_A(SA(1, 1), A, brow + 128, t + 1);
    WAIT_L(8); BAR; WAIT_L(0); MMA(0, 0, At, B0); BAR; SCHED;
    LDB(B1, 0, 1); STAGE_B(SB(0, 0), Bt, bcol, t + 2);
    BAR; WAIT_L(0); MMA(0, 1, At, B1); BAR;
    LDA(At, 0, 1); STAGE_A(SA(0, 0), A, brow, t + 2);
    BAR; WAIT_L(0); MMA(1, 0, At, B0); BAR; SCHED;
    STAGE_B(SB(0, 1), Bt, bcol + 128, t + 2);
    WAIT_V(6); BAR; MMA(1, 1, At, B1); BAR;
    LDB(B0, 1, 0); SCHED; LDA(At, 1, 0); STAGE_A(SA(0, 1), A, brow + 128, t + 2);
    WAIT_L(8); BAR; WAIT_L(0); MMA(0, 0, At, B0); BAR; SCHED;
    LDB(B1, 1, 1); STAGE_B(SB(1, 0), Bt, bcol, t + 3);
    BAR; WAIT_L(0); MMA(0, 1, At, B1); BAR;
    LDA(At, 1, 1); STAGE_A(SA(1, 0), A, brow, t + 3);
    BAR; WAIT_L(0); MMA(1, 0, At, B0); BAR; SCHED;
    STAGE_B(SB(1, 1), Bt, bcol + 128, t + 3);
    WAIT_V(6); BAR; MMA(1, 1, At, B1); BAR;
  }
  { LDB(B0, 0, 0); LDA(At, 0, 0); STAGE_A(SA(1, 1), A, brow + 128, nt - 1);
    BAR; WAIT_L(0); MMA(0, 0, At, B0); BAR;
    LDB(B1, 0, 1); BAR; WAIT_L(0); MMA(0, 1, At, B1); BAR;
    LDA(At, 0, 1); WAIT_V(4); BAR; WAIT_L(0); MMA(1, 0, At, B0); MMA(1, 1, At, B1); BAR; }
  { LDB(B0, 1, 0); LDA(At, 1, 0); WAIT_V(2); BAR; WAIT_L(0); MMA(0, 0, At, B0); BAR;
    LDB(B1, 1, 1); WAIT_V(0); BAR; WAIT_L(0); MMA(0, 1, At, B1); BAR;
    LDA(At, 1, 1); BAR; WAIT_L(0); MMA(1, 0, At, B0); MMA(1, 1, At, B1); BAR; }
  if (wr == 0) BAR;
  if (tnext >= 0) {
    const Tile tn = tile_of<EPI>(layer, tnext);
    const bf16_t* An = A0 + tn.koff; const bf16_t* Bn = Bt0 + tn.koff;
    SCHED; STAGE_B(SB(0, 0), Bn, tn.bcol, 0); SCHED; STAGE_A(SA(0, 0), An, tn.brow, 0); SCHED;
    STAGE_B(SB(0, 1), Bn, tn.bcol + 128, 0); SCHED; STAGE_A(SA(0, 1), An, tn.brow + 128, 0); SCHED;
    STAGE_B(SB(1, 0), Bn, tn.bcol, 1); SCHED; STAGE_A(SA(1, 0), An, tn.brow, 1); SCHED; STAGE_B(SB(1, 1), Bn, tn.bcol + 128, 1); SCHED;
  }
#undef SA
#undef SB
#undef STAGE_A
#undef STAGE_B
#undef LDA
#undef LDB
#undef MMA
#undef WAIT_V
#undef WAIT_L
#undef BAR
#undef SCHED

  const int tid_e = otid();
  const int wr_e = tid_e >> 8, wc_e = (tid_e >> 6) & 3, fr_e = tid_e & 15, fq_e = (tid_e >> 4) & 3;
#define wr wr_e
#define wc wc_e
#define fr fr_e
#define fq fq_e
  if constexpr (EPI == EPI_IN) {
    bf16_t* P = (bf16_t*)(p.ws + OFF_P);
    bf16_t* VT = (bf16_t*)(p.ws + OFF_VT);
    const float2* ROPE = (const float2*)(p.ws + OFF_ROPE);
#pragma unroll
    for (int bj = 0; bj < 2; ++bj) {
      const int cg = (bcol + bj * 128 + wc * 32) >> 5;
      int cat, pcol0 = 0, hv = 0;
      float scale = 1.f;
      if (cg < 8) { cat = 0; pcol0 = cg * 32; scale = 0.125f; }
      else if (cg < 16) { cat = 0; pcol0 = cg * 32; }
      else if (cg < 24) { cat = 1; hv = (cg - 16) >> 1; }
      else if (cg < 32) { cat = 0; pcol0 = cg * 32 - 256; }
      else if (cg < 44) { cat = 0; pcol0 = cg * 32 - 256; scale = QSCALE; }
      else if (cg < 56) { cat = 0; pcol0 = cg * 32 - 256; }
      else if (cg < 68) { cat = 1; hv = 4 + ((cg - 56) >> 1); }
      else if (cg < 80) { cat = 3; pcol0 = 1536 + ((cg - 68) >> 1) * 64 + (cg & 1) * 16; scale = QSCALE; }
      else if (cg < 84) { cat = 3; pcol0 = 1920 + ((cg - 80) >> 1) * 64 + (cg & 1) * 16; }
      else { cat = 1; hv = 10 + ((cg - 84) >> 1); }
#pragma unroll
      for (int ai = 0; ai < 2; ++ai)
#pragma unroll
        for (int m = 0; m < 4; ++m) {
          const int row0 = brow + ai * 128 + wr * 64 + m * 16 + fq * 4;
          const int b = row0 / S, pos0 = row0 - b * S;
          if (cat == 0) {
#pragma unroll
            for (int n = 0; n < 2; ++n)
#pragma unroll
              for (int j = 0; j < 4; ++j) P[(size_t)(row0 + j) * PW + pcol0 + n * 16 + fr] = f2bf(acc[ai][bj][m][n][j] * scale);
          } else if (cat == 3) {
#pragma unroll
            for (int j = 0; j < 4; ++j) {
              float a1 = acc[ai][bj][m][0][j], a2 = acc[ai][bj][m][1][j];
              float o1 = a1, o2 = a2;
              if (pos0 >= L) {
                float2 cs = ROPE[(size_t)(pos0 + j - L) * 32 + (cg & 1) * 16 + fr];
                o1 = a1 * cs.x - a2 * cs.y; o2 = a1 * cs.y + a2 * cs.x;
              }
              P[(size_t)(row0 + j) * PW + pcol0 + fr] = f2bf(o1 * scale);
              P[(size_t)(row0 + j) * PW + pcol0 + fr + 32] = f2bf(o2 * scale);
            }
          } else {
#pragma unroll
            for (int n = 0; n < 2; ++n) {
              uint2 o; o.x = pack2(acc[ai][bj][m][n][0], acc[ai][bj][m][n][1]); o.y = pack2(acc[ai][bj][m][n][2], acc[ai][bj][m][n][3]);
              *(uint2*)(VT + ((size_t)(b * 12 + hv) * 64 + (cg & 1) * 32 + n * 16 + fr) * S + pos0) = o;
            }
          }
        }
    }
  } else if constexpr (EPI == EPI_RES1 || EPI == EPI_RES2) {
    const float* MOD = (const float*)(p.ws + OFF_MOD);
    const int bq = brow / S, mv = (brow - bq * S) < L ? 4 : bq;
    const float* gate = MOD + (size_t)(layer * 5 + mv) * 6144 + (EPI == EPI_RES1 ? 2048 : 5120) + bcol + wc * 32 + fr;
    float gv[2][2];
#pragma unroll
    for (int bj = 0; bj < 2; ++bj)
#pragma unroll
      for (int n = 0; n < 2; ++n) gv[bj][n] = gate[bj * 128 + n * 16];
    float* xbase = xrow(p, brow) + bcol + wc * 32 + fr;
    if (atomic) {
      const int sl = tc.koff >> 8;
      float* sb = (EPI == EPI_RES1 ? (float*)(p.ws + OFF_SLF) + (size_t)sl * NB * L * D : slab_i(p, sl)) + (size_t)bq * L * D + bcol + wc * 32 + fr;
#pragma unroll
      for (int ai = 0; ai < 2; ++ai)
#pragma unroll
        for (int m = 0; m < 4; ++m)
#pragma unroll
          for (int j = 0; j < 4; ++j) {
            float* xr = sb + (size_t)(ai * 128 + wr * 64 + m * 16 + fq * 4 + j) * D;
#pragma unroll
            for (int bj = 0; bj < 2; ++bj)
#pragma unroll
              for (int n = 0; n < 2; ++n) xr[bj * 128 + n * 16] = gv[bj][n] * acc[ai][bj][m][n][j];
          }
    } else {
#pragma unroll
      for (int ai = 0; ai < 2; ++ai)
#pragma unroll
        for (int m = 0; m < 4; ++m)
#pragma unroll
          for (int j = 0; j < 4; ++j) {
            float* xr = xbase + (size_t)(ai * 128 + wr * 64 + m * 16 + fq * 4 + j) * D;
#pragma unroll
            for (int bj = 0; bj < 2; ++bj)
#pragma unroll
              for (int n = 0; n < 2; ++n) xr[bj * 128 + n * 16] += gv[bj][n] * acc[ai][bj][m][n][j];
          }
    }
  } else {
    bf16_t* ACT = (bf16_t*)(p.ws + OFF_P);
#pragma unroll
    for (int bj = 0; bj < 2; ++bj) {
      const int cg = (bcol + bj * 128 + wc * 32) >> 5;
#pragma unroll
      for (int ai = 0; ai < 2; ++ai)
#pragma unroll
        for (int m = 0; m < 4; ++m) {
          const int row0 = brow + ai * 128 + wr * 64 + m * 16 + fq * 4;
#pragma unroll
          for (int j = 0; j < 4; ++j) {
            float gv = acc[ai][bj][m][0][j], uv = acc[ai][bj][m][1][j];
            ACT[(size_t)(row0 + j) * DFF + cg * 16 + fr] = f2bf(silu_f(gv) * uv);
          }
        }
    }
  }
}

#undef wr
#undef wc
#undef fr
#undef fq

DI void za_item(const Params& p, int layer, int item, char* smem) {
  const int tid = otid(), lane = tid & 63, w = tid >> 6, l15 = lane & 15, g = lane >> 4;
  const bf16_t* H = (const bf16_t*)(p.ws + OFF_H);
  const bf16_t* W = (const bf16_t*)(p.ws + OFF_WIN) + ((size_t)layer * NIN_ROWS + NIN) * D;
  float* ZA = (float*)(p.ws + OFF_ZA);
  float* sZ = (float*)smem;
  const int row0 = item * 64 + (w & 3) * 16, kh = (w >> 2) * 512;
  const bf16_t* ap = H + (size_t)(row0 + l15) * D + kh + g * 8;
  const bf16_t* b0p = W + (size_t)l15 * D + kh + g * 8;
  const bf16_t* b1p = W + (size_t)(16 + l15) * D + kh + g * 8;
  f32x4 c0 = (f32x4){0.f, 0.f, 0.f, 0.f}, c1 = (f32x4){0.f, 0.f, 0.f, 0.f};
#pragma unroll
  for (int hb = 0; hb < 2; ++hb) {
    bf16x8 a[8], b0[8], b1[8];
#pragma unroll
    for (int k = 0; k < 8; ++k) { a[k] = *(const bf16x8*)(ap + (hb * 8 + k) * 32); b0[k] = *(const bf16x8*)(b0p + (hb * 8 + k) * 32); b1[k] = *(const bf16x8*)(b1p + (hb * 8 + k) * 32); }
#pragma unroll
    for (int k = 0; k < 8; ++k) { c0 = MFMA16(a[k], b0[k], c0); c1 = MFMA16(a[k], b1[k], c1); }
  }
  __syncthreads();
  if (w >= 4) { *(f32x4*)(sZ + (((w & 3) * 2 + 0) * 64 + lane) * 4) = c0; *(f32x4*)(sZ + (((w & 3) * 2 + 1) * 64 + lane) * 4) = c1; }
  __syncthreads();
  if (w < 4) {
    c0 += *(const f32x4*)(sZ + ((w * 2 + 0) * 64 + lane) * 4);
    c1 += *(const f32x4*)(sZ + ((w * 2 + 1) * 64 + lane) * 4);
#pragma unroll
    for (int j = 0; j < 4; ++j) {
      ZA[(size_t)(row0 + g * 4 + j) * 32 + l15] = c0[j];
      ZA[(size_t)(row0 + g * 4 + j) * 32 + 16 + l15] = c1[j];
    }
  }
}

DI void attn_item(const Params& p, int layer, int kind, int b, int h, int qt, char* smem) {
  char* sK = smem;
  char* sV = smem + 16384;
  float* sBias = (float*)(smem + 32768);
  const bf16_t* P = (const bf16_t*)(p.ws + OFF_P);
  const bf16_t* VT = (const bf16_t*)(p.ws + OFF_VT);
  bf16_t* Y = (bf16_t*)(p.ws + OFF_H);
  const int tid = otid(), lane = tid & 63, w = tid >> 6, l15 = lane & 15, g = lane >> 4;
  const bool is_swa = (kind == 0 || kind == 2), is_ctxq = kind >= 2;
  const int qcol = is_swa ? 1536 + h * 64 : 768 + h * 64;
  const int kcol = is_swa ? 1920 + (h / 3) * 64 : 1152 + h * 64;
  const int hv = is_swa ? 10 + h / 3 : 4 + h;
  const int ycol = is_swa ? 640 + h * 64 : 256 + h * 64;
  const int qpos0 = is_ctxq ? qt * 128 : L + qt * 128;
  const size_t rowbase = (size_t)b * S;
  int lt0 = 0, nlt = 0, rs_q = 0;
  const int rq = 2 * qt + (w >> 2);
  if (kind == 0) { int lo = qt * 128 - 128, hi = qt * 128 + 256; lo = lo < 0 ? 0 : lo; hi = hi > T ? T : hi; lt0 = L + lo; nlt = (hi - lo) >> 6; }
  else if (kind == 1) {
    int r0 = 2 * qt, rs0 = r0 - 4, rs1 = r0 - 3;
    rs0 = rs0 < 0 ? 0 : (rs0 > 56 ? 56 : rs0); rs1 = rs1 < 0 ? 0 : (rs1 > 56 ? 56 : rs1);
    lt0 = L + rs0 * 64; nlt = rs1 - rs0 + 8;
    rs_q = rq - 4; rs_q = rs_q < 0 ? 0 : (rs_q > 56 ? 56 : rs_q);
  }
  const int ntiles = 4 + nlt;
  const int lr = tid >> 3, c8 = tid & 7;
  const bf16_t* kbase = P + (rowbase + lr) * PW + kcol + c8 * 8;
  const bf16_t* vbase = VT + ((size_t)(b * 12 + hv) * 64 + lr) * S + c8 * 8;
  const int wofs = lds_byte(lr, c8 * 8);
  const int krow_l = 8 * (l15 >> 2) + (l15 & 3);
  const int kofs0 = lds_byte(krow_l, g * 8), kofs1 = lds_byte(krow_l + 4, g * 8);
  const int vofs = lds_byte(l15, g * 8);
  u32x4 kr = *(const u32x4*)(kbase), vr = *(const u32x4*)(vbase);
  __syncthreads();
  if (kind == 1 && tid < 480) { int dr = tid >> 5, dc = tid & 31; sBias[tid] = dc < 31 ? p.na_rpb[(size_t)(layer * 6 + h) * 465 + dr * 31 + dc] * LOG2E : -INFINITY; }
  *(u32x4*)(sK + wofs) = kr; *(u32x4*)(sV + wofs) = vr;
  kr = *(const u32x4*)(kbase + (size_t)64 * PW); vr = *(const u32x4*)(vbase + 64);
  const bf16_t* qp = P + (rowbase + qpos0 + w * 16 + l15) * PW + qcol + g * 8;
  const bf16x8 aq0 = *(const bf16x8*)qp, aq1 = *(const bf16x8*)(qp + 32);
  f32x4 o[4];
#pragma unroll
  for (int i = 0; i < 4; ++i) o[i] = (f32x4){0.f, 0.f, 0.f, 0.f};
  float m = -1e30f, ls = 0.f;
  const int tq = qt * 128 + w * 16 + l15;
  const int tq0 = qt * 128 + w * 16;
  int boff[16];
  {
    const int qi = (w & 3) * 16 + l15;
    int wsr = qi - 8; wsr = wsr < 0 ? 0 : (wsr > 48 ? 48 : wsr);
#pragma unroll
    for (int nt = 0; nt < 4; ++nt)
#pragma unroll
      for (int j = 0; j < 4; ++j) {
        int kk = 32 * (nt >> 1) + 8 * g + 4 * (nt & 1) + j;
        bool valid = (kk >= wsr) && (kk < wsr + 16);
        boff[nt * 4 + j] = valid ? kk - qi + 15 : 31;
      }
  }
  __syncthreads();
  for (int it = 0; it < ntiles; ++it) {
    const int cur = it & 1;
    const int pos0 = it < 4 ? it * 64 : lt0 + (it - 4) * 64;
    if (it + 1 < ntiles) {
      *(u32x4*)(sK + (cur ^ 1) * 8192 + wofs) = kr; *(u32x4*)(sV + (cur ^ 1) * 8192 + wofs) = vr;
      if (it + 2 < ntiles) {
        const int np0 = (it + 2) < 4 ? (it + 2) * 64 : lt0 + (it + 2 - 4) * 64;
        kr = *(const u32x4*)(kbase + (size_t)np0 * PW); vr = *(const u32x4*)(vbase + np0);
      }
    }
    bool skip = false, needmask = false;
    int krow = 0;
    if (it >= 4) {
      if (kind == 0) {
        const int tk0 = pos0 - L;
        skip = (tq0 - (tk0 + 63) > 128) || (tk0 - (tq0 + 15) > 128);
        needmask = !((tq0 + 15 - tk0 <= 128) && (tk0 + 63 - tq0 <= 128));
      } else {
        krow = (pos0 - L) >> 6;
        skip = !((krow >= rs_q) && (krow < rs_q + 8));
        needmask = true;
      }
    }
    if (!skip) {
      const char* kb = sK + cur * 8192;
      const char* vb = sV + cur * 8192 + vofs;
      f32x4 s[4];
#pragma unroll
      for (int ks = 0; ks < 2; ++ks) {
        bf16x8 k00 = *(const bf16x8*)(kb + kofs0 + ks * 4096), k01 = *(const bf16x8*)(kb + kofs0 + ks * 4096 + 1024);
        bf16x8 k10 = *(const bf16x8*)(kb + kofs1 + ks * 4096), k11 = *(const bf16x8*)(kb + kofs1 + ks * 4096 + 1024);
        s[2 * ks] = MFMA16(k00, aq0, ((f32x4){0.f, 0.f, 0.f, 0.f}));
        s[2 * ks] = MFMA16(k01, aq1, s[2 * ks]);
        s[2 * ks + 1] = MFMA16(k10, aq0, ((f32x4){0.f, 0.f, 0.f, 0.f}));
        s[2 * ks + 1] = MFMA16(k11, aq1, s[2 * ks + 1]);
      }
      if (needmask) {
        if (kind == 0) {
          const int tk0 = pos0 - L;
#pragma unroll
          for (int nt = 0; nt < 4; ++nt)
#pragma unroll
            for (int j = 0; j < 4; ++j) {
              int df = tq - (tk0 + 32 * (nt >> 1) + 8 * g + 4 * (nt & 1) + j); df = df < 0 ? -df : df;
              if (df > 128) s[nt][j] = -INFINITY;
            }
        } else {
          const float* brow = sBias + (krow - rq + 7) * 32;
#pragma unroll
          for (int nt = 0; nt < 4; ++nt)
#pragma unroll
            for (int j = 0; j < 4; ++j) s[nt][j] += brow[boff[nt * 4 + j]];
        }
      }
      float mx = fmaxf(fmaxf(fmaxf(s[0][0], s[0][1]), fmaxf(s[0][2], s[0][3])), fmaxf(fmaxf(s[1][0], s[1][1]), fmaxf(s[1][2], s[1][3])));
      mx = fmaxf(mx, fmaxf(fmaxf(fmaxf(s[2][0], s[2][1]), fmaxf(s[2][2], s[2][3])), fmaxf(fmaxf(s[3][0], s[3][1]), fmaxf(s[3][2], s[3][3]))));
      mx = fmaxf(mx, xor_lane(mx, lane, 16));
      mx = fmaxf(mx, xor_lane(mx, lane, 32));
      if (__builtin_amdgcn_ballot_w64(mx > m + 8.f) != 0ull) {
        const float mn = fmaxf(m, mx);
        const float alpha = __builtin_amdgcn_exp2f(m - mn);
        m = mn;
        ls *= alpha;
#pragma unroll
        for (int et = 0; et < 4; ++et) { o[et][0] *= alpha; o[et][1] *= alpha; o[et][2] *= alpha; o[et][3] *= alpha; }
      }
      float psum = 0.f;
#pragma unroll
      for (int nt = 0; nt < 4; ++nt)
#pragma unroll
        for (int j = 0; j < 4; ++j) { float pv = __builtin_amdgcn_exp2f(s[nt][j] - m); s[nt][j] = pv; psum += pv; }
      ls += psum;
#pragma unroll
      for (int ks = 0; ks < 2; ++ks) {
        u32x4 pk; pk.x = pack2(s[2 * ks][0], s[2 * ks][1]); pk.y = pack2(s[2 * ks][2], s[2 * ks][3]);
        pk.z = pack2(s[2 * ks + 1][0], s[2 * ks + 1][1]); pk.w = pack2(s[2 * ks + 1][2], s[2 * ks + 1][3]);
        const bf16x8 pb = __builtin_bit_cast(bf16x8, pk);
#pragma unroll
        for (int et = 0; et < 4; ++et) {
          bf16x8 vf = *(const bf16x8*)(vb + et * 2048 + ks * 1024);
          o[et] = MFMA16(vf, pb, o[et]);
        }
      }
    }
    __syncthreads();
  }
  ls += xor_lane(ls, lane, 16);
  ls += xor_lane(ls, lane, 32);
  float f;
  if (is_swa) {
    const float sink = p.swa_sink[layer * 6 + h] * LOG2E;
    float M = fmaxf(m, sink);
    float a = __builtin_amdgcn_exp2f(m - M);
    f = a / (ls * a + __builtin_amdgcn_exp2f(sink - M));
  } else {
    f = 1.f / ls;
  }
  bf16_t* yp = Y + (rowbase + qpos0 + w * 16 + l15) * D + ycol + g * 4;
#pragma unroll
  for (int et = 0; et < 4; ++et) {
    uint2 ov; ov.x = pack2(o[et][0] * f, o[et][1] * f); ov.y = pack2(o[et][2] * f, o[et][3] * f);
    *(uint2*)(yp + et * 16) = ov;
  }
}

DI void na2_item(const Params& p, int layer, int b, int h, int qt, char* smem) {
  char* sK = smem;
  char* sV = smem + 32768;
  float* sBias = (float*)(smem + 65536);
  const bf16_t* P = (const bf16_t*)(p.ws + OFF_P);
  const bf16_t* VT = (const bf16_t*)(p.ws + OFF_VT);
  bf16_t* Y = (bf16_t*)(p.ws + OFF_H);
  const int tid = otid(), lane = tid & 63, w = tid >> 6, l15 = lane & 15, g = lane >> 4;
  const int qcol = 768 + h * 64, kcol = 1152 + h * 64, hv = 4 + h, ycol = 256 + h * 64;
  const size_t rowbase = (size_t)b * S;
  const int rq = 2 * qt + (w >> 2), c0 = 16 * (w & 3);
  int rs0 = 2 * qt - 4, rs1 = 2 * qt - 3, rs_q = rq - 4;
  rs0 = rs0 < 0 ? 0 : (rs0 > 56 ? 56 : rs0); rs1 = rs1 < 0 ? 0 : (rs1 > 56 ? 56 : rs1); rs_q = rs_q < 0 ? 0 : (rs_q > 56 ? 56 : rs_q);
  const int npair = (rs1 - rs0 + 9) >> 1, ntiles = 4 + npair;
  int kc0 = c0 - 8; kc0 = kc0 < 0 ? 0 : (kc0 > 32 ? 32 : kc0);
  const int lr = tid >> 3, c8 = tid & 7;
  const bf16_t* kbase = P + (rowbase + lr) * PW + kcol + c8 * 8;
  const bf16_t* vbase = VT + ((size_t)(b * 12 + hv) * 64 + lr) * S + c8 * 8;
  const int wofs = lds_byte(lr, c8 * 8);
  const int kl = 8 * (l15 >> 2) + (l15 & 3);
  const int kofs0 = lds_byte(kl, g * 8), kofs1 = lds_byte(kl + 4, g * 8);
  const int lk0 = lds_byte(kc0 + kl, g * 8), lk1 = lds_byte(kc0 + kl + 4, g * 8);
  const int vofs = lds_byte(l15, g * 8);
  const int lvofs = lds_byte(l15, kc0 + g * 8);
  auto pos_of = [&](int it, int r) -> int { if (it < 4) return 64 * it; int kr_ = rs0 + 2 * (it - 4) + r; kr_ = kr_ > 63 ? 63 : kr_; return L + kr_ * 64; };
  u32x4 kr0 = *(const u32x4*)(kbase), vr0 = *(const u32x4*)(vbase), kr1, vr1;
  kr1 = kr0; vr1 = vr0;
  __syncthreads();
  if (tid < 480) { int dr = tid >> 5, dc = tid & 31; sBias[tid] = dc < 31 ? p.na_rpb[(size_t)(layer * 6 + h) * 465 + dr * 31 + dc] * LOG2E : -INFINITY; }
  *(u32x4*)(sK + wofs) = kr0; *(u32x4*)(sV + wofs) = vr0;
  kr0 = *(const u32x4*)(kbase + (size_t)64 * PW); vr0 = *(const u32x4*)(vbase + 64);
  const bf16_t* qp = P + (rowbase + L + rq * 64 + c0 + l15) * PW + qcol + g * 8;
  const bf16x8 aq0 = *(const bf16x8*)qp, aq1 = *(const bf16x8*)(qp + 32);
  f32x4 o[4];
#pragma unroll
  for (int i = 0; i < 4; ++i) o[i] = (f32x4){0.f, 0.f, 0.f, 0.f};
  float m = -1e30f, ls = 0.f;
  int boff[8];
  {
    const int qi = c0 + l15;
    int wsr = qi - 8; wsr = wsr < 0 ? 0 : (wsr > 48 ? 48 : wsr);
#pragma unroll
    for (int hh = 0; hh < 2; ++hh)
#pragma unroll
      for (int j = 0; j < 4; ++j) {
        int kk = kc0 + 8 * g + 4 * hh + j;
        boff[hh * 4 + j] = ((kk >= wsr) && (kk < wsr + 16)) ? kk - qi + 15 : 31;
      }
  }
  __syncthreads();
  for (int it = 0; it < ntiles; ++it) {
    const int cur = it & 1;
    if (it + 1 < ntiles) {
      char* dk = sK + (cur ^ 1) * 16384 + wofs; char* dv = sV + (cur ^ 1) * 16384 + wofs;
      *(u32x4*)dk = kr0; *(u32x4*)dv = vr0;
      if (it + 1 >= 4) { *(u32x4*)(dk + 8192) = kr1; *(u32x4*)(dv + 8192) = vr1; }
      if (it + 2 < ntiles) {
        const int pa = pos_of(it + 2, 0);
        kr0 = *(const u32x4*)(kbase + (size_t)pa * PW); vr0 = *(const u32x4*)(vbase + pa);
        if (it + 2 >= 4) { const int pb_ = pos_of(it + 2, 1); kr1 = *(const u32x4*)(kbase + (size_t)pb_ * PW); vr1 = *(const u32x4*)(vbase + pb_); }
      }
    }
    const char* kb = sK + cur * 16384;
    const char* vb = sV + cur * 16384;
    f32x4 s[4];
    bool act0 = true, act1 = true;
    if (it < 4) {
#pragma unroll
      for (int ks = 0; ks < 2; ++ks) {
        bf16x8 k00 = *(const bf16x8*)(kb + kofs0 + ks * 4096), k01 = *(const bf16x8*)(kb + kofs0 + ks * 4096 + 1024);
        bf16x8 k10 = *(const bf16x8*)(kb + kofs1 + ks * 4096), k11 = *(const bf16x8*)(kb + kofs1 + ks * 4096 + 1024);
        s[2 * ks] = MFMA16(k00, aq0, ((f32x4){0.f, 0.f, 0.f, 0.f}));
        s[2 * ks] = MFMA16(k01, aq1, s[2 * ks]);
        s[2 * ks + 1] = MFMA16(k10, aq0, ((f32x4){0.f, 0.f, 0.f, 0.f}));
        s[2 * ks + 1] = MFMA16(k11, aq1, s[2 * ks + 1]);
      }
    } else {
      const int krA = rs0 + 2 * (it - 4);
      act0 = (krA >= rs_q) && (krA < rs_q + 8);
      act1 = (krA + 1 >= rs_q) && (krA + 1 < rs_q + 8);
#pragma unroll
      for (int ks = 0; ks < 2; ++ks) {
        const bool act = ks == 0 ? act0 : act1;
        if (act) {
          const char* kbr = kb + ks * 8192;
          bf16x8 k00 = *(const bf16x8*)(kbr + lk0), k01 = *(const bf16x8*)(kbr + lk0 + 1024);
          bf16x8 k10 = *(const bf16x8*)(kbr + lk1), k11 = *(const bf16x8*)(kbr + lk1 + 1024);
          s[2 * ks] = MFMA16(k00, aq0, ((f32x4){0.f, 0.f, 0.f, 0.f}));
          s[2 * ks] = MFMA16(k01, aq1, s[2 * ks]);
          s[2 * ks + 1] = MFMA16(k10, aq0, ((f32x4){0.f, 0.f, 0.f, 0.f}));
          s[2 * ks + 1] = MFMA16(k11, aq1, s[2 * ks + 1]);
          const float* brow = sBias + (krA + ks - rq + 7) * 32;
#pragma unroll
          for (int hh = 0; hh < 2; ++hh)
#pragma unroll
            for (int j = 0; j < 4; ++j) s[2 * ks + hh][j] += brow[boff[hh * 4 + j]];
        } else {
          s[2 * ks] = (f32x4){-INFINITY, -INFINITY, -INFINITY, -INFINITY};
          s[2 * ks + 1] = s[2 * ks];
        }
      }
    }
    if (act0 || act1) {
      float mx = fmaxf(fmaxf(fmaxf(s[0][0], s[0][1]), fmaxf(s[0][2], s[0][3])), fmaxf(fmaxf(s[1][0], s[1][1]), fmaxf(s[1][2], s[1][3])));
      mx = fmaxf(mx, fmaxf(fmaxf(fmaxf(s[2][0], s[2][1]), fmaxf(s[2][2], s[2][3])), fmaxf(fmaxf(s[3][0], s[3][1]), fmaxf(s[3][2], s[3][3]))));
      mx = fmaxf(mx, xor_lane(mx, lane, 16));
      mx = fmaxf(mx, xor_lane(mx, lane, 32));
      if (__builtin_amdgcn_ballot_w64(mx > m + 8.f) != 0ull) {
        const float mn = fmaxf(m, mx);
        const float alpha = __builtin_amdgcn_exp2f(m - mn);
        m = mn;
        ls *= alpha;
#pragma unroll
        for (int et = 0; et < 4; ++et) { o[et][0] *= alpha; o[et][1] *= alpha; o[et][2] *= alpha; o[et][3] *= alpha; }
      }
      float psum = 0.f;
#pragma unroll
      for (int nt = 0; nt < 4; ++nt)
#pragma unroll
        for (int j = 0; j < 4; ++j) { float pv = __builtin_amdgcn_exp2f(s[nt][j] - m); s[nt][j] = pv; psum += pv; }
      ls += psum;
#pragma unroll
      for (int ks = 0; ks < 2; ++ks) {
        const bool act = ks == 0 ? act0 : act1;
        if (act) {
          u32x4 pk; pk.x = pack2(s[2 * ks][0], s[2 * ks][1]); pk.y = pack2(s[2 * ks][2], s[2 * ks][3]);
          pk.z = pack2(s[2 * ks + 1][0], s[2 * ks + 1][1]); pk.w = pack2(s[2 * ks + 1][2], s[2 * ks + 1][3]);
          const bf16x8 pb = __builtin_bit_cast(bf16x8, pk);
          const char* vp = it < 4 ? vb + vofs + ks * 1024 : vb + ks * 8192 + lvofs;
#pragma unroll
          for (int et = 0; et < 4; ++et) {
            bf16x8 vf = *(const bf16x8*)(vp + et * 2048);
            o[et] = MFMA16(vf, pb, o[et]);
          }
        }
      }
    }
    __syncthreads();
  }
  ls += xor_lane(ls, lane, 16);
  ls += xor_lane(ls, lane, 32);
  const float f = 1.f / ls;
  bf16_t* yp = Y + (rowbase + L + rq * 64 + c0 + l15) * D + ycol + g * 4;
#pragma unroll
  for (int et = 0; et < 4; ++et) {
    uint2 ov; ov.x = pack2(o[et][0] * f, o[et][1] * f); ov.y = pack2(o[et][2] * f, o[et][3] * f);
    *(uint2*)(yp + et * 16) = ov;
  }
}

DI void swa3_item(const Params& p, int layer, int b, int kvh, int qt, char* smem) {
  char* sK = smem;
  char* sV = smem + 16384;
  const bf16_t* P = (const bf16_t*)(p.ws + OFF_P);
  const bf16_t* VT = (const bf16_t*)(p.ws + OFF_VT);
  bf16_t* Y = (bf16_t*)(p.ws + OFF_H);
  const int tid = otid(), lane = tid & 63, w = tid >> 6, l15 = lane & 15, g = lane >> 4;
  const int kcol = 1920 + kvh * 64, hv = 10 + kvh;
  const int qpos0 = L + qt * 128;
  const size_t rowbase = (size_t)b * S;
  int lo = qt * 128 - 128, hi = qt * 128 + 256; lo = lo < 0 ? 0 : lo; hi = hi > T ? T : hi;
  const int lt0 = L + lo, ntiles = 4 + ((hi - lo) >> 6);
  const int lr = tid >> 3, c8 = tid & 7;
  const bf16_t* kbase = P + (rowbase + lr) * PW + kcol + c8 * 8;
  const bf16_t* vbase = VT + ((size_t)(b * 12 + hv) * 64 + lr) * S + c8 * 8;
  const int wofs = lds_byte(lr, c8 * 8);
  const int krow_l = 8 * (l15 >> 2) + (l15 & 3);
  const int kofs0 = lds_byte(krow_l, g * 8), kofs1 = lds_byte(krow_l + 4, g * 8);
  const int vofs = lds_byte(l15, g * 8);
  u32x4 kr = *(const u32x4*)(kbase), vr = *(const u32x4*)(vbase);
  __syncthreads();
  *(u32x4*)(sK + wofs) = kr; *(u32x4*)(sV + wofs) = vr;
  kr = *(const u32x4*)(kbase + (size_t)64 * PW); vr = *(const u32x4*)(vbase + 64);
  bf16x8 aq[3][2];
#pragma unroll
  for (int hd = 0; hd < 3; ++hd) {
    const bf16_t* qp = P + (rowbase + qpos0 + w * 16 + l15) * PW + 1536 + (kvh * 3 + hd) * 64 + g * 8;
    aq[hd][0] = *(const bf16x8*)qp; aq[hd][1] = *(const bf16x8*)(qp + 32);
  }
  f32x4 o[3][4];
  float m[3], ls[3];
  float minit = -1e30f; asm volatile("" : "+v"(minit));
#pragma unroll
  for (int hd = 0; hd < 3; ++hd) {
    m[hd] = minit; ls[hd] = 0.f;
#pragma unroll
    for (int i = 0; i < 4; ++i) o[hd][i] = (f32x4){0.f, 0.f, 0.f, 0.f};
  }
  const int tq = qt * 128 + w * 16 + l15;
  const int tq0 = qt * 128 + w * 16;
  __syncthreads();
  for (int it = 0; it < ntiles; ++it) {
    const int cur = it & 1;
    const int pos0 = it < 4 ? it * 64 : lt0 + (it - 4) * 64;
    if (it + 1 < ntiles) {
      *(u32x4*)(sK + (cur ^ 1) * 8192 + wofs) = kr; *(u32x4*)(sV + (cur ^ 1) * 8192 + wofs) = vr;
      if (it + 2 < ntiles) {
        const int np0 = (it + 2) < 4 ? (it + 2) * 64 : lt0 + (it + 2 - 4) * 64;
        kr = *(const u32x4*)(kbase + (size_t)np0 * PW); vr = *(const u32x4*)(vbase + np0);
      }
    }
    bool skip = false, needmask = false;
    const int tk0 = pos0 - L;
    if (it >= 4) {
      skip = (tq0 - (tk0 + 63) > 128) || (tk0 - (tq0 + 15) > 128);
      needmask = !((tq0 + 15 - tk0 <= 128) && (tk0 + 63 - tq0 <= 128));
    }
    if (!skip) {
      const char* kb = sK + cur * 8192;
      const char* vb = sV + cur * 8192 + vofs;
      f32x4 s[3][4];
      __builtin_amdgcn_s_setprio(1);
#pragma unroll
      for (int ks = 0; ks < 2; ++ks) {
        const bf16x8 k00 = *(const bf16x8*)(kb + kofs0 + ks * 4096), k01 = *(const bf16x8*)(kb + kofs0 + ks * 4096 + 1024);
        const bf16x8 k10 = *(const bf16x8*)(kb + kofs1 + ks * 4096), k11 = *(const bf16x8*)(kb + kofs1 + ks * 4096 + 1024);
#pragma unroll
        for (int hd = 0; hd < 3; ++hd) {
          s[hd][2 * ks] = MFMA16(k00, aq[hd][0], ((f32x4){0.f, 0.f, 0.f, 0.f}));
          s[hd][2 * ks] = MFMA16(k01, aq[hd][1], s[hd][2 * ks]);
          s[hd][2 * ks + 1] = MFMA16(k10, aq[hd][0], ((f32x4){0.f, 0.f, 0.f, 0.f}));
          s[hd][2 * ks + 1] = MFMA16(k11, aq[hd][1], s[hd][2 * ks + 1]);
        }
      }
      __builtin_amdgcn_s_setprio(0);
      if (needmask) {
#pragma unroll
        for (int nt = 0; nt < 4; ++nt)
#pragma unroll
          for (int j = 0; j < 4; ++j) {
            int df = tq - (tk0 + 32 * (nt >> 1) + 8 * g + 4 * (nt & 1) + j); df = df < 0 ? -df : df;
            if (df > 128) { s[0][nt][j] = -INFINITY; s[1][nt][j] = -INFINITY; s[2][nt][j] = -INFINITY; }
          }
      }
      bf16x8 pb[3][2];
#pragma unroll
      for (int hd = 0; hd < 3; ++hd) {
        float mx = fmaxf(fmaxf(fmaxf(s[hd][0][0], s[hd][0][1]), fmaxf(s[hd][0][2], s[hd][0][3])), fmaxf(fmaxf(s[hd][1][0], s[hd][1][1]), fmaxf(s[hd][1][2], s[hd][1][3])));
        mx = fmaxf(mx, fmaxf(fmaxf(fmaxf(s[hd][2][0], s[hd][2][1]), fmaxf(s[hd][2][2], s[hd][2][3])), fmaxf(fmaxf(s[hd][3][0], s[hd][3][1]), fmaxf(s[hd][3][2], s[hd][3][3]))));
        mx = fmaxf(mx, xor_lane(mx, lane, 16));
        mx = fmaxf(mx, xor_lane(mx, lane, 32));
        if (__builtin_amdgcn_ballot_w64(mx > m[hd] + 8.f) != 0ull) {
          const float mn = fmaxf(m[hd], mx);
          const float alpha = __builtin_amdgcn_exp2f(m[hd] - mn);
          m[hd] = mn;
          ls[hd] *= alpha;
#pragma unroll
          for (int et = 0; et < 4; ++et) { o[hd][et][0] *= alpha; o[hd][et][1] *= alpha; o[hd][et][2] *= alpha; o[hd][et][3] *= alpha; }
        }
        float psum = 0.f;
#pragma unroll
        for (int nt = 0; nt < 4; ++nt)
#pragma unroll
          for (int j = 0; j < 4; ++j) { float pv = __builtin_amdgcn_exp2f(s[hd][nt][j] - m[hd]); s[hd][nt][j] = pv; psum += pv; }
        ls[hd] += psum;
#pragma unroll
        for (int ks = 0; ks < 2; ++ks) {
          u32x4 pk; pk.x = pack2(s[hd][2 * ks][0], s[hd][2 * ks][1]); pk.y = pack2(s[hd][2 * ks][2], s[hd][2 * ks][3]);
          pk.z = pack2(s[hd][2 * ks + 1][0], s[hd][2 * ks + 1][1]); pk.w = pack2(s[hd][2 * ks + 1][2], s[hd][2 * ks + 1][3]);
          pb[hd][ks] = __builtin_bit_cast(bf16x8, pk);
        }
      }
      __builtin_amdgcn_s_setprio(1);
#pragma unroll
      for (int ks = 0; ks < 2; ++ks)
#pragma unroll
        for (int et = 0; et < 4; ++et) {
          const bf16x8 vf = *(const bf16x8*)(vb + et * 2048 + ks * 1024);
#pragma unroll
          for (int hd = 0; hd < 3; ++hd) o[hd][et] = MFMA16(vf, pb[hd][ks], o[hd][et]);
        }
      __builtin_amdgcn_s_setprio(0);
    }
    __syncthreads();
  }
#pragma unroll
  for (int hd = 0; hd < 3; ++hd) {
    const int hq = kvh * 3 + hd;
    float l = ls[hd];
    l += xor_lane(l, lane, 16);
    l += xor_lane(l, lane, 32);
    const float sink = p.swa_sink[layer * 6 + hq] * LOG2E;
    const float M = fmaxf(m[hd], sink);
    const float a = __builtin_amdgcn_exp2f(m[hd] - M);
    const float f = a / (l * a + __builtin_amdgcn_exp2f(sink - M));
    bf16_t* yp = Y + (rowbase + qpos0 + w * 16 + l15) * D + 640 + hq * 64 + g * 4;
#pragma unroll
    for (int et = 0; et < 4; ++et) {
      uint2 ov; ov.x = pack2(o[hd][et][0] * f, o[hd][et][1] * f); ov.y = pack2(o[hd][et][2] * f, o[hd][et][3] * f);
      *(uint2*)(yp + et * 16) = ov;
    }
  }
}

DI void na4_item(const Params& p, int layer, int b, int h, int qt4, char* smem) {
  char* sK = smem;
  char* sV = smem + 32768;
  float* sBias = (float*)(smem + 65536);
  const bf16_t* P = (const bf16_t*)(p.ws + OFF_P);
  const bf16_t* VT = (const bf16_t*)(p.ws + OFF_VT);
  bf16_t* Y = (bf16_t*)(p.ws + OFF_H);
  const int tid = otid(), lane = tid & 63, w = tid >> 6, l15 = lane & 15, g = lane >> 4;
  const int qcol = 768 + h * 64, kcol = 1152 + h * 64, hv = 4 + h, ycol = 256 + h * 64;
  const size_t rowbase = (size_t)b * S;
  const int r0 = 4 * qt4, c0 = 16 * (w & 3);
  int rq[2], rsq[2];
#pragma unroll
  for (int q = 0; q < 2; ++q) { rq[q] = r0 + (w >> 2) + 2 * q; int t_ = rq[q] - 4; rsq[q] = t_ < 0 ? 0 : (t_ > 56 ? 56 : t_); }
  int rs0 = r0 - 4, rsL = r0 - 1;
  rs0 = rs0 < 0 ? 0 : (rs0 > 56 ? 56 : rs0); rsL = rsL < 0 ? 0 : (rsL > 56 ? 56 : rsL);
  const int npair = (rsL - rs0 + 9) >> 1, ntiles = 4 + npair;
  int kc0 = c0 - 8; kc0 = kc0 < 0 ? 0 : (kc0 > 32 ? 32 : kc0);
  const int lr = tid >> 3, c8 = tid & 7;
  const bf16_t* kbase = P + (rowbase + lr) * PW + kcol + c8 * 8;
  const bf16_t* vbase = VT + ((size_t)(b * 12 + hv) * 64 + lr) * S + c8 * 8;
  const int wofs = lds_byte(lr, c8 * 8);
  const int kl = 8 * (l15 >> 2) + (l15 & 3);
  const int kofs0 = lds_byte(kl, g * 8), kofs1 = lds_byte(kl + 4, g * 8);
  const int lk0 = lds_byte(kc0 + kl, g * 8), lk1 = lds_byte(kc0 + kl + 4, g * 8);
  const int vofs = lds_byte(l15, g * 8);
  const int lvofs = lds_byte(l15, kc0 + g * 8);
  auto pos_of = [&](int it, int r) -> int { if (it < 4) return 64 * it; int kr_ = rs0 + 2 * (it - 4) + r; kr_ = kr_ > 63 ? 63 : kr_; return L + kr_ * 64; };
  u32x4 kr0 = *(const u32x4*)(kbase), vr0 = *(const u32x4*)(vbase), kr1, vr1;
  kr1 = kr0; vr1 = vr0;
  __syncthreads();
  if (tid < 480) { int dr = tid >> 5, dc = tid & 31; sBias[tid] = dc < 31 ? p.na_rpb[(size_t)(layer * 6 + h) * 465 + dr * 31 + dc] * LOG2E : -INFINITY; }
  *(u32x4*)(sK + wofs) = kr0; *(u32x4*)(sV + wofs) = vr0;
  kr0 = *(const u32x4*)(kbase + (size_t)64 * PW); vr0 = *(const u32x4*)(vbase + 64);
  bf16x8 aq[2][2];
  f32x4 o[2][4];
  float m[2], ls[2];
  float minit = -1e30f; asm volatile("" : "+v"(minit));
#pragma unroll
  for (int q = 0; q < 2; ++q) {
    const bf16_t* qp = P + (rowbase + L + rq[q] * 64 + c0 + l15) * PW + qcol + g * 8;
    aq[q][0] = *(const bf16x8*)qp; aq[q][1] = *(const bf16x8*)(qp + 32);
    m[q] = minit; ls[q] = 0.f;
#pragma unroll
    for (int i = 0; i < 4; ++i) o[q][i] = (f32x4){0.f, 0.f, 0.f, 0.f};
  }
  int boff[8];
  {
    const int qi = c0 + l15;
    int wsr = qi - 8; wsr = wsr < 0 ? 0 : (wsr > 48 ? 48 : wsr);
#pragma unroll
    for (int hh = 0; hh < 2; ++hh)
#pragma unroll
      for (int j = 0; j < 4; ++j) {
        int kk = kc0 + 8 * g + 4 * hh + j;
        boff[hh * 4 + j] = ((kk >= wsr) && (kk < wsr + 16)) ? kk - qi + 15 : 31;
      }
  }
  __syncthreads();
  for (int it = 0; it < ntiles; ++it) {
    const int cur = it & 1;
    if (it + 1 < ntiles) {
      char* dk = sK + (cur ^ 1) * 16384 + wofs; char* dv = sV + (cur ^ 1) * 16384 + wofs;
      *(u32x4*)dk = kr0; *(u32x4*)dv = vr0;
      if (it + 1 >= 4) { *(u32x4*)(dk + 8192) = kr1; *(u32x4*)(dv + 8192) = vr1; }
      if (it + 2 < ntiles) {
        const int pa = pos_of(it + 2, 0);
        kr0 = *(const u32x4*)(kbase + (size_t)pa * PW); vr0 = *(const u32x4*)(vbase + pa);
        if (it + 2 >= 4) { const int pb_ = pos_of(it + 2, 1); kr1 = *(const u32x4*)(kbase + (size_t)pb_ * PW); vr1 = *(const u32x4*)(vbase + pb_); }
      }
    }
    const char* kb = sK + cur * 16384;
    const char* vb = sV + cur * 16384;
    const bool loc = it >= 4;
    const int krA = rs0 + 2 * (it - 4);
    bool act[2][2];
#pragma unroll
    for (int q = 0; q < 2; ++q)
#pragma unroll
      for (int ks = 0; ks < 2; ++ks) act[q][ks] = !loc || ((krA + ks >= rsq[q]) && (krA + ks < rsq[q] + 8));
    f32x4 s[2][4];
#pragma unroll
    for (int ks = 0; ks < 2; ++ks) {
      if (act[0][ks] || act[1][ks]) {
        const char* k0p = loc ? kb + ks * 8192 + lk0 : kb + kofs0 + ks * 4096;
        const char* k1p = loc ? kb + ks * 8192 + lk1 : kb + kofs1 + ks * 4096;
        const bf16x8 k00 = *(const bf16x8*)k0p, k01 = *(const bf16x8*)(k0p + 1024);
        const bf16x8 k10 = *(const bf16x8*)k1p, k11 = *(const bf16x8*)(k1p + 1024);
#pragma unroll
        for (int q = 0; q < 2; ++q) {
          if (act[q][ks]) {
            s[q][2 * ks] = MFMA16(k00, aq[q][0], ((f32x4){0.f, 0.f, 0.f, 0.f}));
            s[q][2 * ks] = MFMA16(k01, aq[q][1], s[q][2 * ks]);
            s[q][2 * ks + 1] = MFMA16(k10, aq[q][0], ((f32x4){0.f, 0.f, 0.f, 0.f}));
            s[q][2 * ks + 1] = MFMA16(k11, aq[q][1], s[q][2 * ks + 1]);
            if (loc) {
              const float* brow = sBias + (krA + ks - rq[q] + 7) * 32;
#pragma unroll
              for (int hh = 0; hh < 2; ++hh)
#pragma unroll
                for (int j = 0; j < 4; ++j) s[q][2 * ks + hh][j] += brow[boff[hh * 4 + j]];
            }
          }
        }
      }
#pragma unroll
      for (int q = 0; q < 2; ++q)
        if (!act[q][ks]) { s[q][2 * ks] = (f32x4){-INFINITY, -INFINITY, -INFINITY, -INFINITY}; s[q][2 * ks + 1] = s[q][2 * ks]; }
    }
    bf16x8 pb[2][2];
#pragma unroll
    for (int q = 0; q < 2; ++q) {
      if (act[q][0] || act[q][1]) {
        float mx = fmaxf(fmaxf(fmaxf(s[q][0][0], s[q][0][1]), fmaxf(s[q][0][2], s[q][0][3])), fmaxf(fmaxf(s[q][1][0], s[q][1][1]), fmaxf(s[q][1][2], s[q][1][3])));
        mx = fmaxf(mx, fmaxf(fmaxf(fmaxf(s[q][2][0], s[q][2][1]), fmaxf(s[q][2][2], s[q][2][3])), fmaxf(fmaxf(s[q][3][0], s[q][3][1]), fmaxf(s[q][3][2], s[q][3][3]))));
        mx = fmaxf(mx, xor_lane(mx, lane, 16));
        mx = fmaxf(mx, xor_lane(mx, lane, 32));
        if (__builtin_amdgcn_ballot_w64(mx > m[q] + 8.f) != 0ull) {
          const float mn = fmaxf(m[q], mx);
          const float alpha = __builtin_amdgcn_exp2f(m[q] - mn);
          m[q] = mn;
          ls[q] *= alpha;
#pragma unroll
          for (int et = 0; et < 4; ++et) { o[q][et][0] *= alpha; o[q][et][1] *= alpha; o[q][et][2] *= alpha; o[q][et][3] *= alpha; }
        }
        float psum = 0.f;
#pragma unroll
        for (int nt = 0; nt < 4; ++nt)
#pragma unroll
          for (int j = 0; j < 4; ++j) { float pv = __builtin_amdgcn_exp2f(s[q][nt][j] - m[q]); s[q][nt][j] = pv; psum += pv; }
        ls[q] += psum;
      }
#pragma unroll
      for (int ks = 0; ks < 2; ++ks) {
        u32x4 pk; pk.x = pack2(s[q][2 * ks][0], s[q][2 * ks][1]); pk.y = pack2(s[q][2 * ks][2], s[q][2 * ks][3]);
        pk.z = pack2(s[q][2 * ks + 1][0], s[q][2 * ks + 1][1]); pk.w = pack2(s[q][2 * ks + 1][2], s[q][2 * ks + 1][3]);
        pb[q][ks] = __builtin_bit_cast(bf16x8, pk);
      }
    }
    __builtin_amdgcn_s_setprio(1);
#pragma unroll
    for (int ks = 0; ks < 2; ++ks) {
      if (act[0][ks] || act[1][ks]) {
        const char* vp = loc ? vb + ks * 8192 + lvofs : vb + vofs + ks * 1024;
#pragma unroll
        for (int et = 0; et < 4; ++et) {
          const bf16x8 vf = *(const bf16x8*)(vp + et * 2048);
#pragma unroll
          for (int q = 0; q < 2; ++q) if (act[q][ks]) o[q][et] = MFMA16(vf, pb[q][ks], o[q][et]);
        }
      }
    }
    __builtin_amdgcn_s_setprio(0);
    __syncthreads();
  }
#pragma unroll
  for (int q = 0; q < 2; ++q) {
    float l = ls[q];
    l += xor_lane(l, lane, 16);
    l += xor_lane(l, lane, 32);
    const float f = 1.f / l;
    bf16_t* yp = Y + (rowbase + L + rq[q] * 64 + c0 + l15) * D + ycol + g * 4;
#pragma unroll
    for (int et = 0; et < 4; ++et) {
      uint2 ov; ov.x = pack2(o[q][et][0] * f, o[q][et][1] * f); ov.y = pack2(o[q][et][2] * f, o[q][et][3] * f);
      *(uint2*)(yp + et * 16) = ov;
    }
  }
}

struct GlaPre { float4 za; u32x4 v; float w2r[16]; float b2; };
DI void gla_preload(const Params& p, int layer, int b, int h, int c, int dir, int d, GlaPre& g) {
  const int tid = otid();
  const float* ZA = (const float*)(p.ws + OFF_ZA);
  const bf16_t* VT = (const bf16_t*)(p.ws + OFF_VT);
  const size_t row0 = (size_t)b * S + c * 64;
  g.za = *(const float4*)(ZA + row0 * 32 + tid * 4);
  const int lr = tid >> 3, lc = (tid & 7) * 8;
  g.v = *(const u32x4*)(VT + ((size_t)(b * 12 + h) * 64 + lr) * S + c * 64 + lc);
  const float* w2 = (dir == 0 ? p.wa2_f : p.wa2_b) + (size_t)layer * 16 * 256 + h * 64 + d;
#pragma unroll
  for (int r = 0; r < 16; ++r) g.w2r[r] = w2[r * 256];
  g.b2 = (dir == 0 ? p.ba_f : p.ba_b)[layer * 256 + h * 64 + d];
}
DI void gla_stage(const GlaPre& g, float* sZA, bf16_t* sV) {
  const int tid = otid();
  *(float4*)(sZA + tid * 4) = g.za;
  const int lr = tid >> 3, lc = (tid & 7) * 8;
  *(u32x4*)(sV + lr * 72 + lc) = g.v;
}
DI void gla_cum(const GlaPre& gp, int dir, int d, int qtr, const float* sZA, float* sQS  , float (&bc)[16], float& btot) {
  float la[16];
#pragma unroll
  for (int i = 0; i < 16; ++i) {
    const float* zr = sZA + (qtr * 16 + i) * 32 + dir * 16;
    float z = gp.b2;
#pragma unroll
    for (int r = 0; r < 16; ++r) z += zr[r] * gp.w2r[r];
    la[i] = log_sigmoid_f(z) * (1.f / 16.f);
  }
  float run = 0.f;
  if (dir == 0) {
#pragma unroll
    for (int i = 0; i < 16; ++i) { run += la[i]; bc[i] = run; }
  } else {
#pragma unroll
    for (int i = 15; i >= 0; --i) { run += la[i]; bc[i] = run; }
  }
  float* qs = sQS + dir * 256;
  qs[qtr * 64 + d] = run;
  __syncthreads();
  float q0 = qs[d], q1 = qs[64 + d], q2 = qs[128 + d], q3 = qs[192 + d];
  btot = q0 + q1 + q2 + q3;
  float off;
  if (dir == 0) off = (qtr > 0 ? q0 : 0.f) + (qtr > 1 ? q1 : 0.f) + (qtr > 2 ? q2 : 0.f);
  else off = (qtr < 3 ? q3 : 0.f) + (qtr < 2 ? q2 : 0.f) + (qtr < 1 ? q1 : 0.f);
#pragma unroll
  for (int i = 0; i < 16; ++i) bc[i] += off;
}

DI void gla_state_item(const Params& p, int layer, int b, int h, int c, char* smem) {
  bf16_t* sKe = (bf16_t*)smem;
  bf16_t* sV = sKe + 2 * 64 * 72;
  float* sZA = (float*)(sV + 64 * 72);
  float* sQS = sZA + 64 * 32;
  const bf16_t* P = (const bf16_t*)(p.ws + OFF_P);
  const int tid = otid(), lane = tid & 63, l15 = lane & 15, g = lane >> 4;
  const int dir = tid >> 8, wl = (tid >> 6) & 3;
  const int item = ((b * 4 + h) * 2 + dir) * NCH + c;
  bf16_t* sKd = sKe + dir * 64 * 72;
  const size_t row0 = (size_t)b * S + c * 64;
  const f32x4 zav = *(const f32x4*)((const float*)(p.ws + OFF_ZA) + row0 * 32 + tid * 4);
  const int lr = tid >> 3, lc = (tid & 7) * 8;
  const u32x4 vtile = *(const u32x4*)((const bf16_t*)(p.ws + OFF_VT) + ((size_t)(b * 12 + h) * 64 + lr) * S + c * 64 + lc);
  const float* w2 = (dir == 0 ? p.wa2_f : p.wa2_b) + (size_t)layer * 16 * 256 + h * 64 + l15;
  float w2v[4][4], b2v[4];
#pragma unroll
  for (int nt = 0; nt < 4; ++nt) {
#pragma unroll
    for (int kk = 0; kk < 4; ++kk) w2v[nt][kk] = w2[(4 * kk + g) * 256 + nt * 16];
    b2v[nt] = (dir == 0 ? p.ba_f : p.ba_b)[layer * 256 + h * 64 + nt * 16 + l15];
  }
  const bf16_t* kp = P + (row0 + wl * 16 + g * 4) * PW + 256 + h * 64 + l15;
  bf16_t kraw[4][4];
#pragma unroll
  for (int nt = 0; nt < 4; ++nt)
#pragma unroll
    for (int j = 0; j < 4; ++j) kraw[nt][j] = kp[(size_t)j * PW + nt * 16];
  __syncthreads();
  *(f32x4*)(sZA + tid * 4) = zav;
  *(u32x4*)(sV + lr * 72 + lc) = vtile;
  __syncthreads();
  float av[4];
#pragma unroll
  for (int kk = 0; kk < 4; ++kk) av[kk] = sZA[(wl * 16 + l15) * 32 + dir * 16 + 4 * kk + g];
  float bcv[4][4], tot[4];
#pragma unroll
  for (int nt = 0; nt < 4; ++nt) {
    f32x4 z = (f32x4){b2v[nt], b2v[nt], b2v[nt], b2v[nt]};
#pragma unroll
    for (int kk = 0; kk < 4; ++kk) z = __builtin_amdgcn_mfma_f32_16x16x4f32(av[kk], w2v[nt][kk], z, 0, 0, 0);
    float la[4];
#pragma unroll
    for (int j = 0; j < 4; ++j) la[j] = log_sigmoid_f(z[j]) * (1.f / 16.f);
    float run = 0.f;
    if (dir == 0) {
#pragma unroll
      for (int j = 0; j < 4; ++j) { run += la[j]; bcv[nt][j] = run; }
    } else {
#pragma unroll
      for (int j = 3; j >= 0; --j) { run += la[j]; bcv[nt][j] = run; }
    }
    const float p1 = xor_lane(run, lane, 16);
    const float pr = run + p1;
    const float p2 = xor_lane(pr, lane, 32);
    float off;
    if (dir == 0) off = ((g & 1) ? p1 : 0.f) + ((g & 2) ? p2 : 0.f);
    else off = ((g & 1) ? 0.f : p1) + ((g & 2) ? 0.f : p2);
#pragma unroll
    for (int j = 0; j < 4; ++j) bcv[nt][j] += off;
    tot[nt] = pr + p2;
  }
  float* qs = sQS + dir * 256;
  if (g == 0) {
#pragma unroll
    for (int nt = 0; nt < 4; ++nt) qs[wl * 64 + nt * 16 + l15] = tot[nt];
  }
  __syncthreads();
  unsigned short* BC = (unsigned short*)(p.ws + OFF_BC) + (size_t)item * 4096 + (wl * 16 + g * 4) * 64 + l15;
#pragma unroll
  for (int nt = 0; nt < 4; ++nt) {
    const int d = nt * 16 + l15;
    const float q0 = qs[d], q1 = qs[64 + d], q2 = qs[128 + d], q3 = qs[192 + d];
    const float btot = q0 + q1 + q2 + q3;
    float off;
    if (dir == 0) off = (wl > 0 ? q0 : 0.f) + (wl > 1 ? q1 : 0.f) + (wl > 2 ? q2 : 0.f);
    else off = (wl < 3 ? q3 : 0.f) + (wl < 2 ? q2 : 0.f) + (wl < 1 ? q1 : 0.f);
    float ke[4];
#pragma unroll
    for (int j = 0; j < 4; ++j) {
      const float bc = bcv[nt][j] + off;
      float q = fminf(-bc * 2048.f + 0.5f, 65535.f);
      BC[j * 64 + nt * 16] = (unsigned short)(int)q;
      ke[j] = bf2f(kraw[nt][j]) * __expf(btot - bc);
    }
    uint2 o; o.x = pack2(ke[0], ke[1]); o.y = pack2(ke[2], ke[3]);
    *(uint2*)(sKd + d * 72 + wl * 16 + g * 4) = o;
    if (wl == 0 && g == 0) ((float*)(p.ws + OFF_DEC))[(size_t)item * 64 + d] = __expf(btot);
  }
  __syncthreads();
  const bf16x8 a0 = *(const bf16x8*)(sKd + (wl * 16 + l15) * 72 + g * 8), a1 = *(const bf16x8*)(sKd + (wl * 16 + l15) * 72 + 32 + g * 8);
  float* CST = (float*)(p.ws + OFF_CST) + (size_t)item * 4096;
#pragma unroll
  for (int nt = 0; nt < 4; ++nt) {
    const bf16_t* vp = sV + (nt * 16 + l15) * 72 + g * 8;
    bf16x8 b0 = *(const bf16x8*)vp, b1 = *(const bf16x8*)(vp + 32);
    f32x4 acc = MFMA16(a0, b0, ((f32x4){0.f, 0.f, 0.f, 0.f}));
    acc = MFMA16(a1, b1, acc);
    *(f32x4*)(CST + (nt * 16 + l15) * 64 + wl * 16 + g * 4) = acc;
  }
}

DI void gla_scan_item(const Params& p, int item) {
  const int seq = item >> 3, idx = (item & 7) * NTHR + otid(), dir = seq & 1, d = idx & 63;
  float* CST = (float*)(p.ws + OFF_CST) + (size_t)seq * NCH * 4096 + idx;
  const float* DEC = (const float*)(p.ws + OFF_DEC) + (size_t)seq * NCH * 64 + d;
  float state = 0.f;
  for (int s0 = 0; s0 < NCH; s0 += 17) {
    float tv[17], dv[17]; int cc[17];
#pragma unroll
    for (int u = 0; u < 17; ++u) {
      int step = s0 + u;
      cc[u] = dir == 0 ? step : (step < 4 ? 3 - step : 71 - step);
      tv[u] = CST[(size_t)cc[u] * 4096];
      dv[u] = DEC[cc[u] * 64];
    }
#pragma unroll
    for (int u = 0; u < 17; ++u) {
      CST[(size_t)cc[u] * 4096] = state;
      state = dv[u] * state + tv[u];
    }
  }
}

DI void gla_out_item(const Params& p, int layer, int b, int h, int c, char* smem) {
  bf16_t* sQ = (bf16_t*)smem;
  bf16_t* sK = sQ + 2 * 64 * 72;
  bf16_t* sS = sK + 2 * 64 * 72;
  bf16_t* sV = sS + 2 * 64 * 72;
  bf16_t* sP = sV + 64 * 72;
  float* sZA = (float*)(sP + 8 * 16 * 72);
  float* sQS = sZA + 64 * 32;
  float* sO = sQS + 512;
  const bf16_t* P = (const bf16_t*)(p.ws + OFF_P);
  bf16_t* Y = (bf16_t*)(p.ws + OFF_H);
  const int tid = otid(), lane = tid & 63, w = tid >> 6, l15 = lane & 15, g = lane >> 4;
  const int dir = tid >> 8, d = tid & 63, qtr = (tid >> 6) & 3, wl = w & 3;
  const size_t row0 = (size_t)b * S + c * 64;
  bf16_t* sQd = sQ + dir * 64 * 72; bf16_t* sKd = sK + dir * 64 * 72; bf16_t* sSd = sS + dir * 64 * 72;
  const int lr_ = tid >> 3, lc_ = (tid & 7) * 8;
  const u32x4 vtile = *(const u32x4*)((const bf16_t*)(p.ws + OFF_VT) + ((size_t)(b * 12 + h) * 64 + lr_) * S + c * 64 + lc_);
  const unsigned short* BC = (const unsigned short*)(p.ws + OFF_BC) + (size_t)(((b * 4 + h) * 2 + dir) * NCH + c) * 4096 + (qtr * 16) * 64 + d;
  unsigned short bcq[16];
#pragma unroll
  for (int i = 0; i < 16; ++i) bcq[i] = BC[i * 64];
  const bf16_t* qp = P + (row0 + qtr * 16) * PW + h * 64 + d;
  bf16_t qraw[16], kraw[16];
#pragma unroll
  for (int i = 0; i < 16; ++i) { qraw[i] = qp[(size_t)i * PW]; kraw[i] = qp[(size_t)i * PW + 256]; }
  const float* SE = (const float*)(p.ws + OFF_CST) + (size_t)(((b * 4 + h) * 2 + dir) * NCH + c) * 4096;
  const int t8 = tid & 255;
  float4 sev[4];
#pragma unroll
  for (int i = 0; i < 4; ++i) { int idx = i * 256 + t8; sev[i] = *(const float4*)(SE + (idx >> 4) * 64 + (idx & 15) * 4); }
  __syncthreads();
  *(u32x4*)(sV + lr_ * 72 + lc_) = vtile;
#pragma unroll
  for (int i = 0; i < 4; ++i) {
    int idx = i * 256 + t8, e = idx >> 4, d4 = (idx & 15) * 4;
    uint2 pk; pk.x = pack2(sev[i].x, sev[i].y); pk.y = pack2(sev[i].z, sev[i].w);
    *(uint2*)(sSd + e * 72 + d4) = pk;
  }
  f32x4 o[4];
#pragma unroll
  for (int i = 0; i < 4; ++i) o[i] = (f32x4){0.f, 0.f, 0.f, 0.f};
  bf16_t* sPw = sP + w * 16 * 72;
  {
    float bc[16];
#pragma unroll
    for (int i = 0; i < 16; ++i) bc[i] = (float)bcq[i] * (-1.f / 2048.f);
#pragma unroll
    for (int i = 0; i < 16; ++i) {
      sQd[(qtr * 16 + i) * 72 + d] = f2bf(bf2f(qraw[i]) * __expf(bc[i]));
      sKd[(qtr * 16 + i) * 72 + d] = f2bf(bf2f(kraw[i]) * __expf(-bc[i]));
    }
    __syncthreads();
    const bf16x8 aq0 = *(const bf16x8*)(sQd + (wl * 16 + l15) * 72 + g * 8), aq1 = *(const bf16x8*)(sQd + (wl * 16 + l15) * 72 + 32 + g * 8);
#pragma unroll
    for (int nt = 0; nt < 4; ++nt) {
      const bf16_t* kp = sKd + (nt * 16 + l15) * 72 + g * 8;
      bf16x8 b0 = *(const bf16x8*)kp, b1 = *(const bf16x8*)(kp + 32);
      f32x4 s = MFMA16(aq0, b0, ((f32x4){0.f, 0.f, 0.f, 0.f}));
      s = MFMA16(aq1, b1, s);
#pragma unroll
      for (int j = 0; j < 4; ++j) {
        int qi = wl * 16 + g * 4 + j, ki = nt * 16 + l15;
        bool keep = dir == 0 ? (ki <= qi) : (ki >= qi);
        sPw[(g * 4 + j) * 72 + nt * 16 + l15] = f2bf(keep ? s[j] : 0.f);
      }
      const bf16_t* sp = sSd + (nt * 16 + l15) * 72 + g * 8;
      bf16x8 c0 = *(const bf16x8*)sp, c1 = *(const bf16x8*)(sp + 32);
      o[nt] = MFMA16(aq0, c0, o[nt]);
      o[nt] = MFMA16(aq1, c1, o[nt]);
    }
    __syncthreads();
    const bf16x8 ap0 = *(const bf16x8*)(sPw + l15 * 72 + g * 8), ap1 = *(const bf16x8*)(sPw + l15 * 72 + 32 + g * 8);
#pragma unroll
    for (int nt = 0; nt < 4; ++nt) {
      const bf16_t* vp = sV + (nt * 16 + l15) * 72 + g * 8;
      bf16x8 b0 = *(const bf16x8*)vp, b1 = *(const bf16x8*)(vp + 32);
      o[nt] = MFMA16(ap0, b0, o[nt]);
      o[nt] = MFMA16(ap1, b1, o[nt]);
    }
  }
  if (dir == 1) {
#pragma unroll
    for (int nt = 0; nt < 4; ++nt)
#pragma unroll
      for (int j = 0; j < 4; ++j) sO[(wl * 16 + g * 4 + j) * 65 + nt * 16 + l15] = o[nt][j];
  }
  __syncthreads();
  if (dir == 0) {
    const float* gn = p.gla_norm + layer * 256 + h * 64;
#pragma unroll
    for (int j = 0; j < 4; ++j) {
      float ov[4];
#pragma unroll
      for (int nt = 0; nt < 4; ++nt) ov[nt] = o[nt][j] + sO[(wl * 16 + g * 4 + j) * 65 + nt * 16 + l15];
      float ss = ov[0] * ov[0] + ov[1] * ov[1] + ov[2] * ov[2] + ov[3] * ov[3];
      ss = sum16(ss);
      const float rstd = rsqrtf(ss * (1.f / 64.f) + EPS);
      const size_t row = row0 + wl * 16 + g * 4 + j;
#pragma unroll
      for (int nt = 0; nt < 4; ++nt) {
        int e = nt * 16 + l15;
        float gv = bf2f(P[row * PW + 512 + h * 64 + e]);
        Y[row * D + h * 64 + e] = f2bf(ov[nt] * rstd * gn[e] * silu_f(gv));
      }
    }
  }
}

#define XB_TMO      128
#define XB_XCNT(j)  (256  + 64 * (j))
#define XB_XSUB(j)  (1280 + 64 * (j))
#define XB_XGEN(j)  (2304 + 64 * (j))
#define XB_TOP      3328
#define XB_TOPGEN   3392
#define XCD_BAR_WORDS 3456
#define XB_SPIN_CAP (1u << 22)
#define LAS __attribute__((address_space(3)))
DI unsigned xb_ld(unsigned* p) { return __hip_atomic_load(p, __ATOMIC_RELAXED, __HIP_MEMORY_SCOPE_AGENT); }
DI unsigned xb_add(unsigned* p, unsigned v) { return __hip_atomic_fetch_add(p, v, __ATOMIC_RELAXED, __HIP_MEMORY_SCOPE_AGENT); }
DI unsigned xb_xcc_id() { return (unsigned)__builtin_amdgcn_s_getreg((3 << 11) | 20) & 0xFu; }
#define XB_SPIN(cond, bar) do { unsigned _sp = 0; while (cond) { __builtin_amdgcn_s_sleep(1); \
    if ((++_sp & 255u) == 0u) { if (xb_ld(&(bar)[XB_TMO])) break; if (_sp > XB_SPIN_CAP) { atomicAdd(&(bar)[XB_TMO], 1u); break; } } } } while (0)
struct XcdBarrier { unsigned* bar; unsigned x; volatile LAS unsigned* st; };
DI XcdBarrier xcd_barrier_post(unsigned* bar, volatile LAS unsigned* st) {
  XcdBarrier b; b.bar = bar; b.x = 0u; b.st = st;
  if (threadIdx.x == 0) { const unsigned x = xb_xcc_id(); st[2] = x; (void)xb_add(&bar[XB_XCNT(x)], 1u); }
  return b;
}
DI void xcd_barrier_complete(unsigned* bar, unsigned x, unsigned& nloc, unsigned& nx) {
  const unsigned G = gridDim.x * gridDim.y * gridDim.z;
  unsigned sum, cnt, mine, sp = 0u;
  for (;;) {
    sum = 0u; cnt = 0u; mine = 0u;
#pragma unroll
    for (unsigned j = 0; j < 16; ++j) { const unsigned c = xb_ld(&bar[XB_XCNT(j)]); sum += c; cnt += (c > 0u) ? 1u : 0u; mine = (j == x) ? c : mine; }
    if (sum == G) break;
    __builtin_amdgcn_s_sleep(1);
    if ((++sp & 255u) == 0u) { if (xb_ld(&bar[XB_TMO])) break; if (sp > XB_SPIN_CAP) { atomicAdd(&bar[XB_TMO], 1u); break; } }
  }
  nloc = mine > 0u ? mine : 1u; nx = cnt > 0u ? cnt : 1u;
}
DI void xcd_barrier(const XcdBarrier& b) {
  asm volatile("s_waitcnt vmcnt(0)" ::: "memory");
  __syncthreads();
  if (threadIdx.x == 0) {
    unsigned* bar = b.bar;
    __builtin_amdgcn_s_waitcnt(0);
    unsigned nloc = b.st[0], nx = b.st[1];
    const unsigned bx = b.st[2];
    if (nloc == 0u) { xcd_barrier_complete(bar, bx, nloc, nx); b.st[0] = nloc; b.st[1] = nx; }
    const unsigned old = xb_add(&bar[XB_XSUB(bx)], 1u);
    const unsigned gen = old / nloc;
    if (old + 1u == (gen + 1u) * nloc) {
      __builtin_amdgcn_fence(__ATOMIC_RELEASE, "agent");
      asm volatile("s_waitcnt vmcnt(0)" ::: "memory");
      const unsigned og = xb_add(&bar[XB_TOP], 1u);
      const unsigned tg = og / nx;
      if (og + 1u == (tg + 1u) * nx) xb_add(&bar[XB_TOPGEN], 1u);
      else XB_SPIN(xb_ld(&bar[XB_TOPGEN]) == tg, bar);
      __builtin_amdgcn_fence(__ATOMIC_ACQUIRE, "agent");
      xb_add(&bar[XB_XGEN(bx)], 1u);
      asm volatile("s_waitcnt vmcnt(0)" ::: "memory");
    } else {
      XB_SPIN(xb_ld(&bar[XB_XGEN(bx)]) == gen, bar);
      __builtin_amdgcn_fence(__ATOMIC_ACQUIRE, "agent");
      asm volatile("s_waitcnt vmcnt(0)" ::: "memory");
    }
  }
  __syncthreads();
}

constexpr int C_IN = 45 * 8, C_OUT = 16 * 8, C_GU = 88 * 8, C_D = 16 * 22;
constexpr int N_CONV_L = C_IN + C_OUT + C_GU + C_D;
DI void conv_dispatch(const Params& p, int layer, int ci, char* smem) {
  if (ci < C_IN) conv_item(p, 0, layer, ci >> 3, ci & 7, smem);
  else if (ci < C_IN + C_OUT) { ci -= C_IN; conv_item(p, 1, layer, ci >> 3, ci & 7, smem); }
  else if (ci < C_IN + C_OUT + C_GU) { ci -= C_IN + C_OUT; conv_item(p, 2, layer, ci >> 3, ci & 7, smem); }
  else { ci -= C_IN + C_OUT + C_GU; conv_item(p, 3, layer, ci / 22, ci % 22, smem); }
}

DI void tail_conv(const Params& p, int layer, int lo, int hi, int nfull, char* smem) {
  const int bid = blockIdx.x, nb = gridDim.x;
  if (bid >= nfull) for (int ci = lo + bid - nfull; ci < hi; ci += nb - nfull) conv_dispatch(p, layer, ci, smem);
}

#define GRID_SYNC() xcd_barrier(xb)

__global__ void __launch_bounds__(512, 2) fwd_megakernel(Params p) {
  cg::grid_group grid = cg::this_grid();
  extern __shared__ __attribute__((aligned(16))) char smem[];
  __shared__ uint4 xb_words;
  const int nblk = gridDim.x, bid = blockIdx.x;
  if (threadIdx.x == 0) xb_words = make_uint4(0u, 0u, 0u, 0u);
  __syncthreads();
  XcdBarrier xb = xcd_barrier_post((unsigned*)(p.ws + OFF_BAR), (volatile LAS unsigned*)&xb_words);

  {
    constexpr int N_MOD = 768, N_ROPE = 256;
    constexpr int N_TOTAL = N_MOD + N_ROPE + C_IN;
    for (int it = bid; it < N_TOTAL; it += nblk) {
      if (it < N_MOD) mod_item(p, it, smem);
      else if (it < N_MOD + N_ROPE) rope_item(p, it - N_MOD);
      else conv_dispatch(p, 0, it - N_MOD - N_ROPE, smem);
    }
  }
  if (p.ws == nullptr) grid.sync();
  GRID_SYNC();

  const bf16_t* H = (const bf16_t*)(p.ws + OFF_H);
  const bf16_t* ACT = (const bf16_t*)(p.ws + OFF_P);
#pragma unroll 1
  for (int layer = 0; layer < 2; ++layer) {
    const bool last = layer == 1;
    norm_phase(p, layer, 0);
    GRID_SYNC();
    {
      const bf16_t* W = (const bf16_t*)(p.ws + OFF_WIN) + (size_t)layer * NIN_ROWS * D;
      const int nt_n = NIN / 256, ntiles = (R / 256) * nt_n;
      for (int t = bid; t < R / 64; t += nblk) za_item(p, layer, t, smem);
      {
        bool pf = false;
        for (int t = bid; t < ntiles; t += nblk) {
          const int t2 = t + nblk < ntiles ? t + nblk : -1;
          gemm256<EPI_IN>(p, layer, t, pf, t2, smem);
          pf = t2 >= 0;
        }
      }
    }
    GRID_SYNC();
    {
      const int n = NB * 4 * NCH;
      for (int t = bid; t < n; t += nblk) {
        int c = t % NCH, r = t / NCH;
        gla_state_item(p, layer, r >> 2, r & 3, c, smem);
      }
      if (!last) tail_conv(p, 0, C_IN, C_IN + C_OUT + C_GU, n % nblk, smem);
    }
    GRID_SYNC();
    {
      const int n_scan = 256, n_swa = NB * 2 * 32, n_na4 = 256, n_na2 = 2 * (NB * 6 * 16 - 256), n_ctx = last ? 0 : NB * 6 * 2;
      const int total = n_scan + n_swa + n_na4 + n_na2 + 2 * n_ctx;
      unsigned* ctr = (unsigned*)(p.ws + OFF_BAR) + 3520 + 64 * layer;
      int* s_next = (int*)(smem + SMEM_BYTES - 16);
      for (;;) {
        __syncthreads();
        if (threadIdx.x == 0) *s_next = (int)__hip_atomic_fetch_add(ctr, 1u, __ATOMIC_RELAXED, __HIP_MEMORY_SCOPE_AGENT);
        __syncthreads();
        const int t = *s_next;
        if (t >= total) break;
        int u = t;
        if (u < n_scan) { gla_scan_item(p, u); continue; }
        u -= n_scan;
        if (u < n_swa) { swa3_item(p, layer, u >> 6, (u >> 5) & 1, u & 31, smem); continue; }
        u -= n_swa;
        if (u < n_na4) { na4_item(p, layer, u / 96, (u >> 4) % 6, u & 15, smem); continue; }
        u -= n_na4;
        if (u < n_na2) { const int grp = 256 + (u >> 1); na2_item(p, layer, grp / 96, (grp >> 4) % 6, 2 * (grp & 15) + (u & 1), smem); continue; }
        u -= n_na2;
        {
          int kind = 2 + u / n_ctx; u %= n_ctx;
          int qt = u & 1, h = (u >> 1) % 6, b = u / 12;
          attn_item(p, layer, kind, b, h, qt, smem);
        }
      }
    }
    GRID_SYNC();
    {
      const int cpb = last ? 64 : NCH, n = NB * 4 * cpb;
      for (int t = bid; t < n; t += nblk) {
        int c = t % cpb + (last ? 4 : 0), r = t / cpb;
        gla_out_item(p, layer, r >> 2, r & 3, c, smem);
      }
      if (!last) { tail_conv(p, 0, C_IN + C_OUT + C_GU, N_CONV_L, n % nblk, smem);
                   tail_conv(p, 1, 0, C_IN, n % nblk, smem); }
    }
    GRID_SYNC();
    {
      const bf16_t* W = (const bf16_t*)(p.ws + OFF_WOUT) + (size_t)layer * D * D;
      const int ntiles = 256 + (last ? 0 : 64);
      bool pf = false;
      for (int t = bid; t < ntiles; t += nblk) {
        const int t2 = t + nblk < ntiles ? t + nblk : -1;
        gemm256<EPI_RES1>(p, layer, t, pf, t2, smem);
        pf = t2 >= 0;
      }
      if (!last) tail_conv(p, 1, C_IN, C_IN + C_OUT + C_GU, ntiles % nblk, smem);
    }
    GRID_SYNC();
    norm_phase(p, layer, 1);
    GRID_SYNC();
    {
      const bf16_t* W = (const bf16_t*)(p.ws + OFF_WGU) + (size_t)layer * 2 * DFF * D;
      const int mt_n = last ? 64 : 68, ntiles = mt_n * 22;
      bool pf = false;
      for (int t = bid; t < ntiles; t += nblk) {
        const int t2 = t + nblk < ntiles ? t + nblk : -1;
        gemm256<EPI_GU>(p, layer, t, pf, t2, smem);
        pf = t2 >= 0;
      }
    }
    GRID_SYNC();
    {
      const bf16_t* W = (const bf16_t*)(p.ws + OFF_WD) + (size_t)layer * D * DFF;
      const int ntiles = 256 + (last ? 0 : 176);
      bool pf = false;
      for (int t = bid; t < ntiles; t += nblk) {
        const int t2 = t + nblk < ntiles ? t + nblk : -1;
        gemm256<EPI_RES2>(p, layer, t, pf, t2, smem);
        pf = t2 >= 0;
      }
      if (!last) tail_conv(p, 1, C_IN + C_OUT + C_GU, N_CONV_L, ntiles % nblk, smem);
    }
    GRID_SYNC();
  }
  norm_phase(p, 0, 2);
}

extern "C" void kernel_launch(void* const* d_in, const int* in_sizes, int n_in, void* d_out, int out_size, void* d_ws, size_t ws_size,
                              hipStream_t stream) {
  static int grid_blocks = 0;
  if (!grid_blocks) {
    int dev = 0, cus = 0, per_cu = 0;
    (void)hipGetDevice(&dev);
    (void)hipDeviceGetAttribute(&cus, hipDeviceAttributeMultiprocessorCount, dev);
    (void)hipFuncSetAttribute((const void*)fwd_megakernel, hipFuncAttributeMaxDynamicSharedMemorySize, SMEM_BYTES);
    (void)hipOccupancyMaxActiveBlocksPerMultiprocessor(&per_cu, fwd_megakernel, NTHR, SMEM_BYTES);
    (void)hipGetLastError();
    grid_blocks = cus;
    if (ws_size < WS_END) fprintf(stderr, "workspace too small: %zu < %zu\n", ws_size, (size_t)WS_END);
    if (per_cu < 1) fprintf(stderr, "occupancy query reports %d blocks per CU\n", per_cu);
  }
  Params p{};
  const float** f = (const float**)&p;
  for (int i = 0; i < 21; ++i) f[i] = (const float*)d_in[i];
  p.out = (float*)d_out;
  p.ws = (char*)d_ws;
  void* args[] = {&p};
  (void)hipMemsetAsync((char*)d_ws + OFF_BAR, 0, 16384, stream);
  (void)hipMemsetAsync((char*)d_ws + OFF_MOD, 0, (size_t)2 * 5 * 6144 * 4, stream);
  hipError_t e = hipLaunchCooperativeKernel((void*)fwd_megakernel, dim3(grid_blocks), dim3(NTHR), args, SMEM_BYTES, stream);
  if (e != hipSuccess) fprintf(stderr, "cooperative launch failed: %s (grid %d)\n", hipGetErrorString(e), grid_blocks);
}
```
